# Optimizing an MI355X kernel written in HIP

```python
import jax, jax.numpy as jnp
from jax import lax
import numpy as np

D_MODEL = 1024
BATCH = 8
SEQ = 4096
DEPTH = 1
DEC_BATCH = 2
DEC_SEQ = 8192
PAST_LEN = 128

GRID_W = 64
HEAD_DIM = 64
N_Q_HEADS = 8
N_KV_HEADS = 2
Q_PER_KV = N_Q_HEADS // N_KV_HEADS
ATTN_WIDTH = N_Q_HEADS * HEAD_DIM
KV_WIDTH = N_KV_HEADS * HEAD_DIM
POOL_WINDOWS = (2, 4, 8, 16)
N_POOL_GROUPS = len(POOL_WINDOWS)
POOL_WIDTH = D_MODEL - ATTN_WIDTH
POOL_GROUP_DIM = POOL_WIDTH // N_POOL_GROUPS
MIX_WIDTH = ATTN_WIDTH + POOL_WIDTH
IN_WIDTH = ATTN_WIDTH + 2 * KV_WIDTH + POOL_WIDTH
D_FF = 4 * D_MODEL
Q_BLOCK = 128
ROPE_THETA = 10000.0
EPS = 1e-6

kernel_name = "hymba_attn_pool_encoder"


def rmsnorm(x, g):
    xf = x.astype(jnp.float32)
    y = xf * lax.rsqrt(jnp.mean(xf * xf, axis=-1, keepdims=True) + EPS) * g.astype(jnp.float32)
    return y.astype(x.dtype)


def axial_rope_tables(seq_len):
    rows = seq_len // GRID_W
    row_ids = jnp.broadcast_to(jnp.arange(rows, dtype=jnp.float32)[:, None], (rows, GRID_W)).reshape(-1)
    col_ids = jnp.broadcast_to(jnp.arange(GRID_W, dtype=jnp.float32)[None, :], (rows, GRID_W)).reshape(-1)
    n_freq = HEAD_DIM // 4
    inv_freq = ROPE_THETA ** (-jnp.arange(n_freq, dtype=jnp.float32) / n_freq)
    ang = jnp.stack([row_ids[:, None] * inv_freq, col_ids[:, None] * inv_freq], axis=1)
    return jnp.cos(ang), jnp.sin(ang)


def apply_axial_rope(x, cos, sin):
    B, S, H, _ = x.shape
    xr = x.reshape(B, S, H, 2, 2, HEAD_DIM // 4)
    x1, x2 = xr[..., 0, :], xr[..., 1, :]
    c = cos[None, :, None].astype(x.dtype)
    s = sin[None, :, None].astype(x.dtype)
    out = jnp.stack([x1 * c - x2 * s, x2 * c + x1 * s], axis=-2)
    return out.reshape(B, S, H, HEAD_DIM)


def block_swept_gqa(q, k, v):
    B, S = q.shape[:2]
    nblk = S // Q_BLOCK
    scale = HEAD_DIM ** -0.5
    qb = q.reshape(B, nblk, Q_BLOCK, N_KV_HEADS, Q_PER_KV, HEAD_DIM).transpose(1, 0, 2, 3, 4, 5)

    def one_block(qi):
        s = jnp.einsum('bqkgd,bskd->bkgqs', qi, k, preferred_element_type=jnp.float32) * scale
        p = jax.nn.softmax(s, axis=-1).astype(v.dtype)
        return jnp.einsum('bkgqs,bskd->bqkgd', p, v)

    ob = lax.map(one_block, qb)
    return ob.transpose(1, 0, 2, 3, 4, 5).reshape(B, S, ATTN_WIDTH)


def multiscale_pool(u, w_pool, pool_scale):
    B, S, _ = u.shape
    uf = u.astype(jnp.float32).reshape(B, S, N_POOL_GROUPS, POOL_GROUP_DIM)
    cs = jnp.concatenate([jnp.zeros((B, 1, N_POOL_GROUPS, POOL_GROUP_DIM), jnp.float32),
                          jnp.cumsum(uf, axis=1)], axis=1)
    t = jnp.arange(S)[:, None]
    win = jnp.array(POOL_WINDOWS, dtype=jnp.int32)[None, :]
    lo = jnp.clip(t - win // 2, 0, S)
    hi = jnp.clip(t - win // 2 + win, 0, S)
    cnt = (hi - lo).astype(jnp.float32)
    g_idx = jnp.arange(N_POOL_GROUPS)[None, :]
    wsum = cs[:, hi, g_idx, :] - cs[:, lo, g_idx, :]
    d = wsum / cnt[None, :, :, None] - uf
    z = jnp.einsum('bsgc,gce->bsge', d, w_pool.astype(jnp.float32))
    z = z.reshape(B, S, POOL_WIDTH) * pool_scale.astype(jnp.float32)
    return z.astype(u.dtype)


def encoder_layer(x, norm1_g, w_in, q_norm_g, k_norm_g, w_pool, pool_scale, w_out,
                  norm2_g, w_up, w_down, cos, sin):
    B, S, _ = x.shape
    h = rmsnorm(x, norm1_g)
    proj = h @ w_in
    q = proj[..., :ATTN_WIDTH].reshape(B, S, N_Q_HEADS, HEAD_DIM)
    k = proj[..., ATTN_WIDTH:ATTN_WIDTH + KV_WIDTH].reshape(B, S, N_KV_HEADS, HEAD_DIM)
    v = proj[..., ATTN_WIDTH + KV_WIDTH:ATTN_WIDTH + 2 * KV_WIDTH].reshape(B, S, N_KV_HEADS, HEAD_DIM)
    u = proj[..., ATTN_WIDTH + 2 * KV_WIDTH:]
    q = apply_axial_rope(rmsnorm(q, q_norm_g), cos, sin)
    k = apply_axial_rope(rmsnorm(k, k_norm_g), cos, sin)
    a = block_swept_gqa(q, k, v)
    p = multiscale_pool(u, w_pool, pool_scale)
    x = x + jnp.concatenate([a, p], axis=-1) @ w_out
    h2 = rmsnorm(x, norm2_g)
    x = x + jnp.square(jax.nn.relu(h2 @ w_up)) @ w_down
    return x


def run_trunk(x, norm1_g, w_in, q_norm_g, k_norm_g, w_pool, pool_scale, w_out,
              norm2_g, w_up, w_down):
    cos, sin = axial_rope_tables(x.shape[1])
    for l in range(DEPTH):
        x = encoder_layer(x, norm1_g[l], w_in[l], q_norm_g[l], k_norm_g[l], w_pool[l],
                          pool_scale[l], w_out[l], norm2_g[l], w_up[l], w_down[l], cos, sin)
    return x


def setup_inputs(seed: int = 0) -> dict:
    key = jax.random.key(seed)
    ks = jax.random.split(key, 13)
    f32 = jnp.float32

    def nrm(k, shape, scale):
        return jax.random.normal(k, shape, f32) * scale

    return {
        "x_prompt": nrm(ks[0], (BATCH, SEQ, D_MODEL), 1.0),
        "x_sample": nrm(ks[1], (DEC_BATCH, DEC_SEQ, D_MODEL), 1.0),
        "norm1_g": 1.0 + nrm(ks[2], (DEPTH, D_MODEL), 0.05),
        "w_in": nrm(ks[3], (DEPTH, D_MODEL, IN_WIDTH), D_MODEL ** -0.5),
        "q_norm_g": 1.0 + nrm(ks[4], (DEPTH, HEAD_DIM), 0.05),
        "k_norm_g": 1.0 + nrm(ks[5], (DEPTH, HEAD_DIM), 0.05),
        "w_pool": nrm(ks[6], (DEPTH, N_POOL_GROUPS, POOL_GROUP_DIM, POOL_GROUP_DIM), POOL_GROUP_DIM ** -0.5),
        "pool_scale": 1.0 + nrm(ks[7], (DEPTH, POOL_WIDTH), 0.1),
        "w_out": nrm(ks[8], (DEPTH, MIX_WIDTH, D_MODEL), MIX_WIDTH ** -0.5),
        "norm2_g": 1.0 + nrm(ks[9], (DEPTH, D_MODEL), 0.05),
        "w_up": nrm(ks[10], (DEPTH, D_MODEL, D_FF), D_MODEL ** -0.5),
        "w_down": nrm(ks[11], (DEPTH, D_FF, D_MODEL), D_FF ** -0.5),
    }


def reference(x_prompt, x_sample, norm1_g, w_in, q_norm_g, k_norm_g, w_pool, pool_scale,
              w_out, norm2_g, w_up, w_down):
    y_prompt = run_trunk(x_prompt, norm1_g, w_in, q_norm_g, k_norm_g, w_pool, pool_scale,
                         w_out, norm2_g, w_up, w_down)
    y_sample = run_trunk(x_sample, norm1_g, w_in, q_norm_g, k_norm_g, w_pool, pool_scale,
                         w_out, norm2_g, w_up, w_down)
    return (y_prompt, y_sample)
```

```cpp
#define MK_N_LAUNCHES 1
#include <hip/hip_runtime.h>
#include <hip/hip_cooperative_groups.h>
#include <cstdio>
#include <cstdint>
namespace cg = cooperative_groups;
namespace pg8 {
#define PG8_LAS __attribute__((address_space(3)))
typedef unsigned short bf16_t;
typedef short bf16x8 __attribute__((ext_vector_type(8)));
typedef float f32x4 __attribute__((ext_vector_type(4)));
typedef unsigned u32x4 __attribute__((ext_vector_type(4)));
constexpr int BM = 256, BK = 64, HALF = 128, HTB = HALF * BK * 2  , STAGE_BYTES = 8 * HTB, NXCD = 8, WGM = 8;

__host__ __device__ __forceinline__ int lds_byte(int r, int c) { const int st = (r >> 4) * 2 + (c >> 5), rr = r & 15, cc = c & 31, ob = rr * 64 + cc * 2; return st * 1024 + (ob ^ (((ob >> 9) & 1) << 5)); }
__host__ __device__ __forceinline__ void stage_rc(int b, int& R, int& C) { const int st = b / 1024, sb = b % 1024, swz = sb ^ (((sb >> 9) & 1) << 5); R = (st >> 1) * 16 + swz / 64; C = (st & 1) * 32 + (swz % 64) / 2; }
__host__ __device__ __forceinline__ int perm32(int rho) { const int n = rho >> 4, i = rho & 15; return 8 * (i >> 2) + 4 * n + (i & 3); }

struct Unit { int pm, pn, idx; };
struct Gemm { const bf16_t* A; const bf16_t* Bt; int M, N, K; };

struct StaticOrder {
    int nM, nN, nwg, G, c, R, rev;
    __host__ __device__ void init(int M, int N, int G_, int c_, int rev_ = 0) { nM = M / BM; nN = N / BM; nwg = nM * nN; G = G_; c = c_; R = (nwg + G - 1) / G; rev = rev_; }
    __host__ __device__ bool next(int i, Unit& u) const {
        if (i >= R) return false;
        const long L = (long)(rev ? R - 1 - i : i) * G + c; if (L >= nwg) return false;
        int wgid = (int)L; { const int q = nwg / NXCD, r = nwg % NXCD, xcd = wgid % NXCD, off = wgid / NXCD; wgid = (xcd < r ? xcd * (q + 1) : r * (q + 1) + (xcd - r) * q) + off; }
        const int nig = WGM * nN, gid = wgid / nig, fm = gid * WGM, gsz = (nM - fm) < WGM ? (nM - fm) : WGM;
        u.pm = fm + ((wgid % nig) % gsz); u.pn = (wgid % nig) / gsz; u.idx = i; return true;
    }
    __device__ __forceinline__ int pm_at(int i) const {
        if (i >= R) return -1;
        const long L = (long)(rev ? R - 1 - i : i) * G + c; if (L >= nwg) return -1;
        int wgid = (int)L; { const int q = nwg / NXCD, r = nwg % NXCD, xcd = wgid % NXCD, off = wgid / NXCD; wgid = (xcd < r ? xcd * (q + 1) : r * (q + 1) + (xcd - r) * q) + off; }
        const int nig = WGM * nN, gid = wgid / nig, fm = gid * WGM, gsz = (nM - fm) < WGM ? (nM - fm) : WGM;
        return fm + ((wgid % nig) % gsz);
    }
    __device__ __forceinline__ void a_ready(const Unit&) const {}
    __device__ __forceinline__ void done(const Unit&) const {}
};

__device__ __forceinline__ unsigned cvt_pk_bf16(float lo, float hi) { unsigned r; asm volatile("v_cvt_pk_bf16_f32 %0, %1, %2" : "=v"(r) : "v"(lo), "v"(hi)); return r; }

typedef float f32x2 __attribute__((ext_vector_type(2)));
typedef unsigned u32x2 __attribute__((ext_vector_type(2)));
__device__ __forceinline__ float xsum16(float v) { const unsigned u = __builtin_bit_cast(unsigned, v); auto r = __builtin_amdgcn_permlane16_swap(u, u, false, false); return __builtin_bit_cast(float, (unsigned)r[0]) + __builtin_bit_cast(float, (unsigned)r[1]); }
__device__ __forceinline__ float xsum32(float v) { const unsigned u = __builtin_bit_cast(unsigned, v); auto r = __builtin_amdgcn_permlane32_swap(u, u, false, false); return __builtin_bit_cast(float, (unsigned)r[0]) + __builtin_bit_cast(float, (unsigned)r[1]); }
constexpr int ROWS_PROMPT = 8 * 4096;
constexpr float RMS_EPS = 1e-6f;
constexpr float QK_C2 = 0.125f * 1.4426950408889634f;

struct EpiInProj {
    static constexpr bool PERM = true, AFTER_DRAIN = false;
    bf16_t* MIX; bf16_t* KV; bf16_t* U; const float* qg; const float* kg; const float* cosT; const float* sinT;
    __device__ __forceinline__ void operator()(const f32x4 (&acc)[2][2][4][2], const Unit& u, int wr, int wc, int fr, int fq) const {
        const int row0 = u.pm * BM + wr * 64 + fr;
        if (u.pn >= 3 || (u.pn == 2 && wc >= 2)) {
            bf16_t* base; int pitch;
            if (u.pn >= 3) { base = U + (size_t)row0 * 512 + (u.pn - 3) * 256 + wc * 32 + 8 * fq; pitch = 512; }
            else { base = KV + (size_t)row0 * 256 + 128 + (wc - 2) * 64 + 8 * fq; pitch = 256; }
            const int bjs = (u.pn >= 3) ? HALF : 32;
#pragma unroll
            for (int ai = 0; ai < 2; ++ai)
#pragma unroll
                for (int m = 0; m < 4; ++m) { bf16_t* rowp = base + (size_t)(ai * HALF + m * 16) * pitch;
#pragma unroll
                    for (int bj = 0; bj < 2; ++bj) { const f32x4 v0 = acc[ai][bj][m][0], v1 = acc[ai][bj][m][1];
                        u32x4 w; w.x = cvt_pk_bf16(v0[0], v0[1]); w.y = cvt_pk_bf16(v0[2], v0[3]); w.z = cvt_pk_bf16(v1[0], v1[1]); w.w = cvt_pk_bf16(v1[2], v1[3]);
                        *(u32x4*)(rowp + bj * bjs) = w; } }
            return;
        }
        const bool isK = (u.pn == 2);
        const float* g = isK ? kg : qg; const float sc = isK ? 1.f : QK_C2;
        bf16_t* base; int pitch;
        if (isK) { base = KV + (size_t)row0 * 256 + wc * 64 + 8 * fq; pitch = 256; } else { base = MIX + (size_t)row0 * 1024 + (u.pn * 4 + wc) * 64 + 8 * fq; pitch = 1024; }
        f32x4 gv[2][2];
#pragma unroll
        for (int bj = 0; bj < 2; ++bj)
#pragma unroll
            for (int n = 0; n < 2; ++n) gv[bj][n] = *(const f32x4*)(g + 32 * bj + 16 * n + 4 * fq) * sc;
        const int rowt = u.pm * BM; const int t0 = rowt < ROWS_PROMPT ? (rowt & 4095) : ((rowt - ROWS_PROMPT) & 8191);
        const int prow_base = (t0 >> 6) + wr;
#pragma unroll
        for (int ai = 0; ai < 2; ++ai) {
            const int prow = prow_base + 2 * ai;
            const f32x4 cr = *(const f32x4*)(cosT + prow * 16 + 4 * fq), sr = *(const f32x4*)(sinT + prow * 16 + 4 * fq);
#pragma unroll
            for (int m = 0; m < 4; ++m) {
                const int pcol = 16 * m + fr;
                const f32x4 cc = *(const f32x4*)(cosT + pcol * 16 + 4 * fq), sn = *(const f32x4*)(sinT + pcol * 16 + 4 * fq);
                float ss = 0.f;
#pragma unroll
                for (int bj = 0; bj < 2; ++bj)
#pragma unroll
                    for (int n = 0; n < 2; ++n) { const f32x4 x = acc[ai][bj][m][n]; ss += (x[0] * x[0] + x[1] * x[1]) + (x[2] * x[2] + x[3] * x[3]); }
                ss = xsum32(xsum16(ss));
                const float rstd = __builtin_amdgcn_rsqf(ss * (1.0f / 64.0f) + RMS_EPS);
                bf16_t* rowp = base + (size_t)(ai * HALF + m * 16) * pitch;
#pragma unroll
                for (int bj = 0; bj < 2; ++bj) { const f32x4 c = bj == 0 ? cr : cc, s = bj == 0 ? sr : sn;
                    const f32x4 y0 = acc[ai][bj][m][0] * rstd * gv[bj][0], y1 = acc[ai][bj][m][1] * rstd * gv[bj][1];
                    const f32x4 o0 = y0 * c - y1 * s, o1 = y1 * c + y0 * s;
                    u32x4 w; w.x = cvt_pk_bf16(o0[0], o0[1]); w.y = cvt_pk_bf16(o0[2], o0[3]); w.z = cvt_pk_bf16(o1[0], o1[1]); w.w = cvt_pk_bf16(o1[2], o1[3]);
                    *(u32x4*)(rowp + bj * 32) = w; }
            }
        }
    }
};

template <bool RECON> struct EpiResStats {
    static constexpr bool PERM = true, AFTER_DRAIN = false;
    const float* xp; const float* xs; bf16_t* xb; float* stats; const float* xinv; const float* g1;
    __device__ __forceinline__ void operator()(const f32x4 (&acc)[2][2][4][2], const Unit& u, int wr, int wc, int fr, int fq) const {
        const int rowt = u.pm * BM; const float* base = rowt < ROWS_PROMPT ? xp : xs - (size_t)ROWS_PROMPT * 1024;
        const int col0 = u.pn * BM + wc * 32 + 8 * fq;
        f32x4 gi[2][2];
        if constexpr (RECON) {
#pragma unroll
            for (int bj = 0; bj < 2; ++bj)
#pragma unroll
                for (int n = 0; n < 2; ++n) { const f32x4 g = *(const f32x4*)(g1 + col0 + bj * HALF + n * 4); gi[bj][n] = (f32x4){__builtin_amdgcn_rcpf(g[0]), __builtin_amdgcn_rcpf(g[1]), __builtin_amdgcn_rcpf(g[2]), __builtin_amdgcn_rcpf(g[3])}; }
        }
#pragma unroll
        for (int ai = 0; ai < 2; ++ai)
#pragma unroll
            for (int m = 0; m < 4; ++m) { const int r = rowt + ai * HALF + wr * 64 + m * 16 + fr; const size_t off = (size_t)r * 1024 + col0; float ss = 0.f;
                float xi = 0.f; if constexpr (RECON) xi = xinv[r];
#pragma unroll
                for (int bj = 0; bj < 2; ++bj) { f32x4 b0, b1;
                    if constexpr (RECON) { const u32x4 w = *(const u32x4*)(xb + off + bj * HALF);
                        b0 = (f32x4){__builtin_bit_cast(float, w.x << 16), __builtin_bit_cast(float, w.x & 0xffff0000u), __builtin_bit_cast(float, w.y << 16), __builtin_bit_cast(float, w.y & 0xffff0000u)} * xi * gi[bj][0];
                        b1 = (f32x4){__builtin_bit_cast(float, w.z << 16), __builtin_bit_cast(float, w.z & 0xffff0000u), __builtin_bit_cast(float, w.w << 16), __builtin_bit_cast(float, w.w & 0xffff0000u)} * xi * gi[bj][1]; }
                    else { b0 = *(const f32x4*)(base + off + bj * HALF); b1 = *(const f32x4*)(base + off + bj * HALF + 4); }
                    const f32x4 o0 = b0 + acc[ai][bj][m][0], o1 = b1 + acc[ai][bj][m][1];
                    ss += ((o0[0] * o0[0] + o0[1] * o0[1]) + (o0[2] * o0[2] + o0[3] * o0[3])) + ((o1[0] * o1[0] + o1[1] * o1[1]) + (o1[2] * o1[2] + o1[3] * o1[3]));
                    u32x4 w2; w2.x = cvt_pk_bf16(o0[0], o0[1]); w2.y = cvt_pk_bf16(o0[2], o0[3]); w2.z = cvt_pk_bf16(o1[0], o1[1]); w2.w = cvt_pk_bf16(o1[2], o1[3]); *(u32x4*)(xb + off + bj * HALF) = w2; }
                ss = xsum32(xsum16(ss));
                if (fq == 0) stats[(size_t)r * 16 + u.pn * 4 + wc] = ss;
                if (!RECON && m == 3) asm volatile("" ::: "memory"); }
    }
};

constexpr int UP_TAB_ROUNDS = 12;
struct EpiUp {
    static constexpr bool PERM = true, AFTER_DRAIN = false;
    bf16_t* H; const float* stats; const PG8_LAS float* tab;
    __device__ __forceinline__ void operator()(const f32x4 (&acc)[2][2][4][2], const Unit& u, int wr, int wc, int fr, int fq) const {
        const int row0 = u.pm * BM + wr * 64 + fr; const int col0 = u.pn * BM + wc * 32 + 8 * fq;
#pragma unroll
        for (int ai = 0; ai < 2; ++ai)
#pragma unroll
            for (int m = 0; m < 4; ++m) { const int r = row0 + ai * HALF + m * 16;
                float rstd;
                if (u.idx < UP_TAB_ROUNDS) rstd = tab[u.idx * BM + ai * HALF + wr * 64 + m * 16 + fr];
                else { const f32x4 p = *(const f32x4*)(stats + (size_t)r * 16 + 4 * fq); float s = (p[0] + p[1]) + (p[2] + p[3]);
                    s = xsum32(xsum16(s)); rstd = __builtin_amdgcn_rsqf(s * (1.0f / 1024.0f) + RMS_EPS); }
                bf16_t* rowp = H + (size_t)r * 4096 + col0;
#pragma unroll
                for (int bj = 0; bj < 2; ++bj) { f32x4 v0 = acc[ai][bj][m][0] * rstd, v1 = acc[ai][bj][m][1] * rstd;
#pragma unroll
                    for (int e = 0; e < 4; ++e) { const float a = fmaxf(v0[e], 0.f), b = fmaxf(v1[e], 0.f); v0[e] = a * a; v1[e] = b * b; }
                    u32x4 w; w.x = cvt_pk_bf16(v0[0], v0[1]); w.y = cvt_pk_bf16(v0[2], v0[3]); w.z = cvt_pk_bf16(v1[0], v1[1]); w.w = cvt_pk_bf16(v1[2], v1[3]);
                    *(u32x4*)(rowp + bj * HALF) = w; } }
    }
};

struct EpiDown {
    static constexpr bool PERM = true, AFTER_DRAIN = false;
    float* out; const bf16_t* xb;
    __device__ __forceinline__ void operator()(const f32x4 (&acc)[2][2][4][2], const Unit& u, int wr, int wc, int fr, int fq) const {
        const int col0 = u.pn * BM + wc * 32 + 8 * fq;
#pragma unroll
        for (int ai = 0; ai < 2; ++ai)
#pragma unroll
            for (int m = 0; m < 4; ++m) { const int r = u.pm * BM + ai * HALF + wr * 64 + m * 16 + fr; const size_t off = (size_t)r * 1024 + col0;
#pragma unroll
                for (int bj = 0; bj < 2; ++bj) { const u32x4 w = *(const u32x4*)(xb + off + bj * HALF);
                    const f32x4 b0 = {__builtin_bit_cast(float, w.x << 16), __builtin_bit_cast(float, w.x & 0xffff0000u), __builtin_bit_cast(float, w.y << 16), __builtin_bit_cast(float, w.y & 0xffff0000u)};
                    const f32x4 b1 = {__builtin_bit_cast(float, w.z << 16), __builtin_bit_cast(float, w.z & 0xffff0000u), __builtin_bit_cast(float, w.w << 16), __builtin_bit_cast(float, w.w & 0xffff0000u)};
                    *(f32x4*)(out + off + bj * HALF) = b0 + acc[ai][bj][m][0]; *(f32x4*)(out + off + bj * HALF + 4) = b1 + acc[ai][bj][m][1]; } }
    }
};

template <class Epi, class Sched, bool ALIGN_EPI = false, bool SP2 = false>
__device__ __forceinline__ void gemm_phase(PG8_LAS unsigned char* lds, const Gemm g, const Sched& S, const Epi& E) {
    const int tid = threadIdx.x, wid = __builtin_amdgcn_readfirstlane(tid >> 6), lane = tid & 63, wr = wid >> 2, wc = wid & 3, fr = lane & 15, fq = lane >> 4;
    const int K = g.K, nt = K / BK;
    unsigned voffA[2], voffB[2];
#pragma unroll
    for (int i = 0; i < 2; ++i) { int R, C; stage_rc(tid * 16 + i * 8192, R, C); const int Rb = Epi::PERM ? ((R & ~31) + perm32(R & 31)) : R;
        voffA[i] = (unsigned)(R * K + C) * 2u; voffB[i] = (unsigned)(Rb * K + C) * 2u; }
    const size_t kstep = (size_t)(BK * 2);
    const size_t hstep = (size_t)HALF * K * 2;
    const size_t tstep = 2 * hstep;
    const unsigned ldsw = (unsigned)wid * 1024u;
    const int aoff = lds_byte(wr * 64 + fr, fq * 8), boff = lds_byte(wc * 32 + fr, fq * 8);
#define PG8_SA(b, h) (((b) * 2 + (h)) * HTB)
#define PG8_SB(b, h) ((4 + (b) * 2 + (h)) * HTB)
#define PG8_STAGE(bufoff, gbase, voff) do { _Pragma("unroll") for (int _i = 0; _i < 2; ++_i) \
        __builtin_amdgcn_global_load_lds((const unsigned*)((const char*)(gbase) + (voff)[_i]), (PG8_LAS unsigned*)(lds + (bufoff) + ldsw + _i * 8192), 16, 0, 0); } while (0)
#define PG8_LDA(dst, b, h) do { _Pragma("unroll") for (int m = 0; m < 4; ++m) _Pragma("unroll") for (int k = 0; k < 2; ++k) dst[m][k] = *(const PG8_LAS bf16x8*)(lds + PG8_SA(b, h) + aoff + m * 2048 + k * 1024); } while (0)
#define PG8_LDB(dst, b, h) do { _Pragma("unroll") for (int n = 0; n < 2; ++n) _Pragma("unroll") for (int k = 0; k < 2; ++k) dst[n][k] = *(const PG8_LAS bf16x8*)(lds + PG8_SB(b, h) + boff + n * 2048 + k * 1024); } while (0)
#define PG8_MMA(ai, bj, At, Bt) do { __builtin_amdgcn_s_setprio(1); _Pragma("unroll") for (int m = 0; m < 4; ++m) _Pragma("unroll") for (int n = 0; n < 2; ++n) _Pragma("unroll") for (int k = 0; k < 2; ++k) \
        acc[ai][bj][m][n] = __builtin_amdgcn_mfma_f32_16x16x32_bf16(Bt[n][k], At[m][k], acc[ai][bj][m][n], 0, 0, 0); __builtin_amdgcn_s_setprio(0); } while (0)
#define PG8_WAIT_V(n) asm volatile("s_waitcnt vmcnt(" #n ")" ::: "memory")
#define PG8_WAIT_L(n) asm volatile("s_waitcnt lgkmcnt(" #n ")" ::: "memory")
#define PG8_BAR __builtin_amdgcn_s_barrier()
#define PG8_SCHED __builtin_amdgcn_sched_barrier(0)
    Unit cur, nxt; int ui = 0;
    if (!S.next(0, cur)) return;
    f32x4 acc[2][2][4][2];
#pragma unroll
    for (int a = 0; a < 2; ++a)
#pragma unroll
        for (int b = 0; b < 2; ++b)
#pragma unroll
            for (int m = 0; m < 4; ++m)
#pragma unroll
                for (int n = 0; n < 2; ++n) acc[a][b][m][n] = (f32x4){0.f, 0.f, 0.f, 0.f};
    bf16x8 At[4][2], B0[2][2], B1[2][2];
    const char* cA = (const char*)g.A + (size_t)cur.pm * tstep; const char* cB = (const char*)g.Bt + (size_t)cur.pn * tstep;
    S.a_ready(cur);
    if constexpr (SP2) {
        PG8_STAGE(PG8_SB(0, 0), cB, voffB); PG8_STAGE(PG8_SB(0, 1), cB + hstep, voffB); PG8_STAGE(PG8_SA(0, 0), cA, voffA); PG8_STAGE(PG8_SA(0, 1), cA + hstep, voffA);
        if (wr == 1) PG8_BAR;
        PG8_WAIT_V(2); PG8_BAR;
        PG8_STAGE(PG8_SB(1, 0), cB + kstep, voffB); PG8_STAGE(PG8_SA(1, 0), cA + kstep, voffA); PG8_STAGE(PG8_SB(1, 1), cB + hstep + kstep, voffB);
        PG8_WAIT_V(6); PG8_BAR;
    } else {
        PG8_STAGE(PG8_SB(0, 0), cB, voffB); PG8_STAGE(PG8_SA(0, 0), cA, voffA); PG8_STAGE(PG8_SB(0, 1), cB + hstep, voffB); PG8_STAGE(PG8_SA(0, 1), cA + hstep, voffA);
        if (wr == 1) PG8_BAR;
        PG8_WAIT_V(4); PG8_BAR;
        PG8_STAGE(PG8_SB(1, 0), cB + kstep, voffB); PG8_STAGE(PG8_SA(1, 0), cA + kstep, voffA); PG8_STAGE(PG8_SB(1, 1), cB + hstep + kstep, voffB);
        PG8_WAIT_V(6); PG8_BAR;
    }
    for (;;) {
        const bool has_next = S.next(ui + 1, nxt);
        const char* nA = has_next ? (const char*)g.A + (size_t)nxt.pm * tstep : cA; const char* nB = has_next ? (const char*)g.Bt + (size_t)nxt.pn * tstep : cB;
        for (int t = 0; t < nt; t += 2) {
            const bool last = (t == nt - 2);
            const char* a1 = cA + (size_t)(t + 1) * kstep;
            const char* a2 = last ? nA : cA + (size_t)(t + 2) * kstep; const char* b2 = last ? nB : cB + (size_t)(t + 2) * kstep;
            const char* a3 = a2 + kstep; const char* b3 = b2 + kstep;
            if (last && has_next) S.a_ready(nxt);
            if constexpr (SP2) {
            PG8_LDB(B0, 0, 0); PG8_LDB(B1, 0, 1); PG8_SCHED; PG8_LDA(At, 0, 0); PG8_STAGE(PG8_SA(1, 1), a1 + hstep, voffA);
            PG8_WAIT_V(8); PG8_WAIT_L(0); PG8_BAR; PG8_MMA(0, 0, At, B0); PG8_MMA(0, 1, At, B1); PG8_BAR; PG8_SCHED;
            PG8_LDA(At, 0, 1); PG8_STAGE(PG8_SB(0, 0), b2, voffB); PG8_STAGE(PG8_SB(0, 1), b2 + hstep, voffB); PG8_STAGE(PG8_SA(0, 0), a2, voffA);
            PG8_WAIT_V(8); PG8_WAIT_L(0); PG8_BAR; PG8_MMA(1, 0, At, B0); PG8_MMA(1, 1, At, B1); PG8_BAR; PG8_SCHED;
            PG8_LDB(B0, 1, 0); PG8_LDB(B1, 1, 1); PG8_SCHED; PG8_LDA(At, 1, 0); PG8_STAGE(PG8_SA(0, 1), a2 + hstep, voffA);
            PG8_WAIT_V(8); PG8_WAIT_L(0); PG8_BAR; PG8_MMA(0, 0, At, B0); PG8_MMA(0, 1, At, B1); PG8_BAR; PG8_SCHED;
            PG8_LDA(At, 1, 1); PG8_STAGE(PG8_SB(1, 0), b3, voffB); PG8_STAGE(PG8_SB(1, 1), b3 + hstep, voffB); PG8_STAGE(PG8_SA(1, 0), a3, voffA);
            PG8_WAIT_V(8); PG8_WAIT_L(0); PG8_BAR; PG8_MMA(1, 0, At, B0); PG8_MMA(1, 1, At, B1); PG8_BAR; PG8_SCHED;
            } else {
            PG8_LDB(B0, 0, 0); PG8_SCHED; PG8_LDA(At, 0, 0); PG8_STAGE(PG8_SA(1, 1), a1 + hstep, voffA);
            PG8_WAIT_L(8); PG8_BAR; PG8_WAIT_L(0); PG8_MMA(0, 0, At, B0); PG8_BAR; PG8_SCHED;
            PG8_LDB(B1, 0, 1); PG8_STAGE(PG8_SB(0, 0), b2, voffB);
            PG8_BAR; PG8_WAIT_L(0); PG8_MMA(0, 1, At, B1); PG8_BAR;
            PG8_LDA(At, 0, 1); PG8_STAGE(PG8_SA(0, 0), a2, voffA);
            PG8_BAR; PG8_WAIT_L(0); PG8_MMA(1, 0, At, B0); PG8_BAR; PG8_SCHED;
            PG8_STAGE(PG8_SB(0, 1), b2 + hstep, voffB);
            PG8_WAIT_V(6); PG8_BAR; PG8_MMA(1, 1, At, B1); PG8_BAR;
            PG8_LDB(B0, 1, 0); PG8_SCHED; PG8_LDA(At, 1, 0); PG8_STAGE(PG8_SA(0, 1), a2 + hstep, voffA);
            PG8_WAIT_L(8); PG8_BAR; PG8_WAIT_L(0); PG8_MMA(0, 0, At, B0); PG8_BAR; PG8_SCHED;
            PG8_LDB(B1, 1, 1); PG8_STAGE(PG8_SB(1, 0), b3, voffB);
            PG8_BAR; PG8_WAIT_L(0); PG8_MMA(0, 1, At, B1); PG8_BAR;
            PG8_LDA(At, 1, 1); PG8_STAGE(PG8_SA(1, 0), a3, voffA);
            PG8_BAR; PG8_WAIT_L(0); PG8_MMA(1, 0, At, B0); PG8_BAR; PG8_SCHED;
            PG8_STAGE(PG8_SB(1, 1), b3 + hstep, voffB);
            PG8_WAIT_V(6); PG8_BAR; PG8_MMA(1, 1, At, B1); PG8_BAR;
            }
        }
        if constexpr (ALIGN_EPI) { if (wr == 0) PG8_BAR; }
        if constexpr (!Epi::AFTER_DRAIN) { E(acc, cur, wr, wc, fr, fq); S.done(cur); }
        if (!has_next) break;
#pragma unroll
        for (int a = 0; a < 2; ++a)
#pragma unroll
            for (int b = 0; b < 2; ++b)
#pragma unroll
                for (int m = 0; m < 4; ++m)
#pragma unroll
                    for (int n = 0; n < 2; ++n) acc[a][b][m][n] = (f32x4){0.f, 0.f, 0.f, 0.f};
        cur = nxt; cA = nA; cB = nB; ++ui;
        if constexpr (ALIGN_EPI) { if (wr == 1) PG8_BAR; }
    }
    PG8_WAIT_V(0);
    if constexpr (!ALIGN_EPI) { if (wr == 0) PG8_BAR; }
    PG8_BAR;
    if constexpr (Epi::AFTER_DRAIN) { E.fused(acc, cur, wr, wc, fr, fq, lds, wid, lane); S.done(cur); }
#undef PG8_SA
#undef PG8_SB
#undef PG8_STAGE
#undef PG8_LDA
#undef PG8_LDB
#undef PG8_MMA
#undef PG8_WAIT_V
#undef PG8_WAIT_L
#undef PG8_BAR
#undef PG8_SCHED
}
}

#ifndef PG8_SP2
#define PG8_SP2 true
#endif
#ifndef PG8_ALIGN
#define PG8_ALIGN true
#endif
#include <hip/hip_bf16.h>
#include <cmath>
namespace attn_body {
using bf16=__hip_bfloat16;
using bf16x8=__attribute__((ext_vector_type(8)))short;
using s16x4=__attribute__((ext_vector_type(4)))short;
using f32x16=__attribute__((ext_vector_type(16)))float;
using u32x4=__attribute__((ext_vector_type(4)))unsigned;
constexpr int D=64,QP=1024,KP=256;
constexpr int NW=8,QBLK=32,QB=QBLK*NW,KVBLK=64;
constexpr int ATTN_UNIT_ROWS=QB;
__device__ __forceinline__ int crow(int r,int hi){return (r&3)+8*(r>>2)+4*hi;}
#define SBAR() __builtin_amdgcn_sched_barrier(0)
constexpr int NSLOT=3, SLOTB=8192;
constexpr int LDS_K=0, LDS_V=NSLOT*SLOTB, LDS_WS=2*NSLOT*SLOTB, LDS_OST=LDS_WS+NW*64*4, LDS_BYTES=LDS_OST+NW*4096;
constexpr float C2=0.125f*1.4426950408889634f;
__device__ __forceinline__ void glds16(const void*gsrc,unsigned lds_dst){unsigned keep;
  asm volatile("s_mov_b32 %0, m0\n\ts_mov_b32 m0, %2\n\ts_nop 0\n\tglobal_load_lds_dwordx4 %1, off\n\ts_mov_b32 m0, %0":"=&s"(keep):"v"(gsrc),"s"(lds_dst):"memory");}
__device__ __forceinline__ float max3f(float a,float b,float c){float r;asm("v_max3_f32 %0, %1, %2, %3":"=v"(r):"v"(a),"v"(b),"v"(c));return r;}
__device__ __forceinline__ float max2f(float a,float b){float r;asm("v_max_f32_e32 %0, %1, %2":"=v"(r):"v"(a),"v"(b));return r;}
__device__ __forceinline__ float fadd_s(float a,float b){float r;asm("v_add_f32_e32 %0, %1, %2":"=v"(r):"v"(a),"v"(b));return r;}
__device__ __forceinline__ float fsub_s(float a,float b){float r;asm("v_sub_f32_e32 %0, %1, %2":"=v"(r):"v"(a),"v"(b));return r;}
typedef float f32x2_t __attribute__((ext_vector_type(2))); typedef __bf16 bf16x2_t __attribute__((ext_vector_type(2)));
__device__ __forceinline__ unsigned cvtpk_s(float lo,float hi){f32x2_t v={lo,hi};bf16x2_t b=__builtin_convertvector(v,bf16x2_t);return __builtin_bit_cast(unsigned,b);}
#define WAIT_BAR(N) asm volatile("s_waitcnt vmcnt(" #N ") lgkmcnt(0)\n\ts_barrier":::"memory")

__device__ __forceinline__ void qkt(f32x16&p0,f32x16&p1,const char*Kslot,const bf16x8*qr,const f32x16&negm,int r32,int hi){
  const char*kb=Kslot+hi*1024+r32*16;
  #pragma unroll
  for(int d0=0;d0<4;++d0){
    const bf16x8 b0=*reinterpret_cast<const bf16x8*>(kb+d0*2048);
    const bf16x8 b1=*reinterpret_cast<const bf16x8*>(kb+d0*2048+512);
    if(d0==0){p0=__builtin_amdgcn_mfma_f32_32x32x16_bf16(b0,qr[0],negm,0,0,0);p1=__builtin_amdgcn_mfma_f32_32x32x16_bf16(b1,qr[0],negm,0,0,0);}
    else{p0=__builtin_amdgcn_mfma_f32_32x32x16_bf16(b0,qr[d0],p0,0,0,0);p1=__builtin_amdgcn_mfma_f32_32x32x16_bf16(b1,qr[d0],p1,0,0,0);}}
}
typedef __attribute__((address_space(3))) const char* lds_cptr;
typedef short v4i16_t __attribute__((ext_vector_type(4)));
__device__ __forceinline__ void kload8(bf16x8*kf,lds_cptr kp){
  kf[0]=*(const __attribute__((address_space(3))) bf16x8*)(kp);      kf[1]=*(const __attribute__((address_space(3))) bf16x8*)(kp+512);
  kf[2]=*(const __attribute__((address_space(3))) bf16x8*)(kp+2048); kf[3]=*(const __attribute__((address_space(3))) bf16x8*)(kp+2560);
  kf[4]=*(const __attribute__((address_space(3))) bf16x8*)(kp+4096); kf[5]=*(const __attribute__((address_space(3))) bf16x8*)(kp+4608);
  kf[6]=*(const __attribute__((address_space(3))) bf16x8*)(kp+6144); kf[7]=*(const __attribute__((address_space(3))) bf16x8*)(kp+6656);
}
__device__ __forceinline__ void kload2(bf16x8*kf,lds_cptr kp,int j){ kf[2*j]=*(const __attribute__((address_space(3))) bf16x8*)(kp+j*2048); kf[2*j+1]=*(const __attribute__((address_space(3))) bf16x8*)(kp+j*2048+512); }
__device__ __forceinline__ s16x4 vtr(lds_cptr p){ return __builtin_bit_cast(s16x4,__builtin_amdgcn_ds_read_tr16_b64_v4i16((__attribute__((address_space(3))) v4i16_t*)p)); }
__device__ __forceinline__ float rowmax(const f32x16&p0,const f32x16&p1){
  float a=max3f(p0[0],p0[1],p1[0]),b=max3f(p0[2],p0[3],p1[1]);a=max3f(a,p1[2],p1[3]);
  #pragma unroll
  for(int r=4;r<16;r+=4){a=max3f(a,p0[r],p0[r+1]);b=max3f(b,p0[r+2],p0[r+3]);a=max3f(a,p1[r],p1[r+1]);b=max3f(b,p1[r+2],p1[r+3]);}
  const float m=max2f(a,b);
  auto rr=__builtin_amdgcn_permlane32_swap(__float_as_uint(m),__float_as_uint(m),false,false);
  return max2f(__uint_as_float(rr[0]),__uint_as_float(rr[1]));
}
__device__ __forceinline__ void pv(f32x16*o,int vb,bf16x8 pa0,bf16x8 pa1,bf16x8 pa2,bf16x8 pa3){
  #pragma unroll
  for(int d0=0;d0<2;++d0){s16x4 lo[4],hi[4];
    #pragma unroll
    for(int ks=0;ks<4;++ks){
      asm volatile("ds_read_b64_tr_b16 %0,%1 offset:%c2":"=&v"(lo[ks]):"v"(vb),"i"(d0*4096+ks*1024):"memory");
      asm volatile("ds_read_b64_tr_b16 %0,%1 offset:%c2":"=&v"(hi[ks]):"v"(vb),"i"(d0*4096+ks*1024+512):"memory");}
    asm volatile("s_waitcnt lgkmcnt(0)":::"memory");SBAR();
    #define PK(k) (bf16x8){lo[k][0],lo[k][1],lo[k][2],lo[k][3],hi[k][0],hi[k][1],hi[k][2],hi[k][3]}
    o[d0]=__builtin_amdgcn_mfma_f32_32x32x16_bf16(pa0,PK(0),o[d0],0,0,0);
    o[d0]=__builtin_amdgcn_mfma_f32_32x32x16_bf16(pa1,PK(1),o[d0],0,0,0);
    o[d0]=__builtin_amdgcn_mfma_f32_32x32x16_bf16(pa2,PK(2),o[d0],0,0,0);
    o[d0]=__builtin_amdgcn_mfma_f32_32x32x16_bf16(pa3,PK(3),o[d0],0,0,0);
    #undef PK
  }
}

#ifndef ATTN_STORE16
#define ATTN_STORE16(p,v) (*(u32x4*)(p)=(v))
#endif
template<int THRL,bool NOMAX> __device__ __forceinline__ void attn_unit(long rowbase,int NT,int h,int qb,const bf16*Q,const bf16*__restrict__ Kh,const bf16*__restrict__ Vh,bf16*O,char*shm,
    bool first,bool has_next,long n_rowbase,int n_h,int n_qb,const bf16*__restrict__ n_Kh,bf16x8 (&qr)[4]){
  const int tid=threadIdx.x,lane=tid&63,r32=lane&31,hi=lane>>5; const int wid=__builtin_amdgcn_readfirstlane(tid>>6);
  const int q0=qb*QB;
  const bf16*Qw=Q+(rowbase+q0+wid*QBLK)*QP+h*D;
  const unsigned lds0=(unsigned)(uintptr_t)shm;
  float*wsf=(float*)(shm+LDS_WS)+wid*64;
  const bf16*ksrc=Kh+(long)lane*KP+wid*8;
  const bf16*vsrc=Vh+(long)(16*(wid&3)+(lane>>2))*KP+(wid>>2)*32+(lane&3)*8;
  const unsigned kdst=lds0+LDS_K+wid*1024, vdst=lds0+LDS_V+wid*1024;
  #define DMA_K(t,slot) glds16(ksrc+(long)(t)*KVBLK*KP,(unsigned)__builtin_amdgcn_readfirstlane(kdst+(slot)))
  #define DMA_V(t,slot) glds16(vsrc+(long)(t)*KVBLK*KP,(unsigned)__builtin_amdgcn_readfirstlane(vdst+(slot)))
  const int vb0=(int)(lds0+LDS_V)+((lane>>4)&1)*32+(lane&3)*8+(4*hi+((lane&15)>>2))*64;
  const char*Kbase=shm+LDS_K; bf16x8 kf[8];
  const lds_cptr shm3=(lds_cptr)shm; const lds_cptr kp0=shm3+LDS_K+hi*1024+r32*16; const lds_cptr vp0=shm3+LDS_V+((lane>>4)&1)*32+(lane&3)*8+(4*hi+((lane&15)>>2))*64;
  if(first){ DMA_K(0,0);DMA_V(0,0);DMA_K(1,SLOTB);
  #pragma unroll
  for(int d0=0;d0<4;++d0)qr[d0]=*reinterpret_cast<const bf16x8*>(&Qw[(long)r32*QP+d0*16+hi*8]); }
  float mhat=0.f,l_reg=0.f;f32x16 o[2];o[0]=f32x16{};o[1]=f32x16{};f32x16 negm=f32x16{};asm volatile("":"+v"(negm));
  #define CMASK(P0,P1,t) do{}while(0)
  bool resc=false;
  #define START(P0,P1) do{ const float rm=rowmax(P0,P1); resc=false; \
    { const float dl=rm; mhat=fadd_s(mhat,dl); \
      _Pragma("unroll") for(int r=0;r<16;++r){P0[r]=fsub_s(P0[r],dl);P1[r]=fsub_s(P1[r],dl);} \
      _Pragma("unroll") for(int r=0;r<16;++r)negm[r]=-mhat; asm volatile("":"+v"(negm)); } \
    _Pragma("unroll") for(int r=0;r<16;++r)P0[r]=__builtin_amdgcn_exp2f(P0[r]); }while(0)
  #define RESC() do{ if(resc){ asm volatile("s_waitcnt lgkmcnt(0)":::"memory"); \
      _Pragma("unroll") for(int d_=0;d_<2;++d_) _Pragma("unroll") for(int r=0;r<16;++r)o[d_][r]*=wsf[crow(r,hi)]; } }while(0)
  f32x16 pA0,pA1,pB0,pB1;
  int sl_prev=0,sl_cur=0,sl_next=SLOTB;
  #define ROT() do{sl_prev=sl_cur;sl_cur=sl_next;sl_next=(sl_next==(NSLOT-1)*SLOTB)?0:sl_next+SLOTB;}while(0)
  if(first){ DMA_K(2,2*SLOTB);
  WAIT_BAR(3); }
  else { DMA_V(0,0); WAIT_BAR(1); }
  qkt(pA0,pA1,Kbase,qr,negm,r32,hi);asm volatile("s_nop 15\n\ts_nop 7":"+v"(pA0),"+v"(pA1));CMASK(pA0,pA1,0);
  START(pA0,pA1);
  _Pragma("unroll") for(int r=0;r<16;++r)pA1[r]=__builtin_amdgcn_exp2f(pA1[r]);
  WAIT_BAR(0);
  DMA_K(3,0);DMA_V(1,SLOTB);
  ROT();
  kload8(kf,kp0+sl_cur);
  WAIT_BAR(2);
  s16x4 vlo[8],vhi[8]; u32x4 pw0,pw1,pw2,pw3;
  #define PKW(P,B) cvtpk_s(P[B],P[B+1])
  #define PAF(k) __builtin_bit_cast(bf16x8,pw##k)
  #define VFR(i) (bf16x8){vlo[i][0],vlo[i][1],vlo[i][2],vlo[i][3],vhi[i][0],vhi[i][1],vhi[i][2],vhi[i][3]}
  #define PIN(x) asm volatile("":"+v"(x))
  #define MX3(a,b,c) __builtin_fmaxf(__builtin_fmaxf((a),(b)),(c))
  #define GAPA(MF,A0,A1,A2,A3,W0,W1,PW) do{ MF; sacc+=A0; sacc+=A1; sacc+=A2; sacc+=A3; PIN(sacc); W0; W1; PIN(PW); SBAR(); }while(0)
  #define EX(v) __builtin_amdgcn_exp2f(v)
  #define GAPB(MF,X,B) do{ MF; X[B]=EX(X[B]); X[B+1]=EX(X[B+1]); X[B+2]=EX(X[B+2]); X[B+3]=EX(X[B+3]); PIN(X); SBAR(); }while(0)
  #define VRD(i) do{ vlo[i]=vtr(vp_+(((i)>>2)*4096+((i)&3)*1024)); vhi[i]=vtr(vp_+(((i)>>2)*4096+((i)&3)*1024+512)); }while(0)
  #define KRD(G,j) do{ if(G){ kload2(kf,kp0+sl_next,j); SBAR(); } }while(0)
  #define STEP(C0,C1,P0,P1,t,GK,GV,GL) do{ SBAR(); \
    const lds_cptr vp_=vp0+sl_prev; \
    VRD(0); SBAR(); float sacc=(P0[0]+P0[1]); \
    GAPA(C0=__builtin_amdgcn_mfma_f32_32x32x16_bf16(kf[0],qr[0],negm,0,0,0), P0[2],P0[3],P0[4],P0[5],     pw0[0]=PKW(P0,0), pw0[1]=PKW(P0,2), pw0); \
    VRD(4); SBAR(); GAPA(C1=__builtin_amdgcn_mfma_f32_32x32x16_bf16(kf[1],qr[0],negm,0,0,0), P0[6],P0[7],P0[8],P0[9],     pw0[2]=PKW(P0,4), pw0[3]=PKW(P0,6), pw0); \
    VRD(1); SBAR(); GAPA(C0=__builtin_amdgcn_mfma_f32_32x32x16_bf16(kf[2],qr[1],C0,0,0,0),   P0[10],P0[11],P0[12],P0[13], pw1[0]=PKW(P0,8), pw1[1]=PKW(P0,10), pw1); \
    VRD(5); SBAR(); GAPA(C1=__builtin_amdgcn_mfma_f32_32x32x16_bf16(kf[3],qr[1],C1,0,0,0),   P0[14],P0[15],P1[0],P1[1],   pw1[2]=PKW(P0,12),pw1[3]=PKW(P0,14), pw1); \
    VRD(2); SBAR(); GAPA(C0=__builtin_amdgcn_mfma_f32_32x32x16_bf16(kf[4],qr[2],C0,0,0,0),   P1[2],P1[3],P1[4],P1[5],     pw2[0]=PKW(P1,0), pw2[1]=PKW(P1,2), pw2); \
    VRD(6); SBAR(); GAPA(C1=__builtin_amdgcn_mfma_f32_32x32x16_bf16(kf[5],qr[2],C1,0,0,0),   P1[6],P1[7],P1[8],P1[9],     pw2[2]=PKW(P1,4), pw2[3]=PKW(P1,6), pw2); \
    VRD(3); SBAR(); GAPA(C0=__builtin_amdgcn_mfma_f32_32x32x16_bf16(kf[6],qr[3],C0,0,0,0),   P1[10],P1[11],P1[12],P1[13], pw3[0]=PKW(P1,8), pw3[1]=PKW(P1,10), pw3); \
    VRD(7); SBAR(); GAPA(C1=__builtin_amdgcn_mfma_f32_32x32x16_bf16(kf[7],qr[3],C1,0,0,0),   P1[14],P1[15],0.f,0.f,       pw3[2]=PKW(P1,12),pw3[3]=PKW(P1,14), pw3); \
    l_reg+=sacc; \
    if(GK){DMA_K((t)+3,sl_cur);} if(GV){DMA_V((t)+1,sl_next);} \
    CMASK(C0,C1,t); \
    if constexpr(NOMAX){ resc=false; } else { float a=MX3(C0[0],C0[1],C1[0]),b=MX3(C0[2],C0[3],C1[1]); a=MX3(a,C1[2],C1[3]); \
      _Pragma("unroll") for(int r=4;r<16;r+=4){a=MX3(a,C0[r],C0[r+1]);b=MX3(b,C0[r+2],C0[r+3]);a=MX3(a,C1[r],C1[r+1]);b=MX3(b,C1[r+2],C1[r+3]);} \
      float rm=__builtin_fmaxf(a,b); { auto rr=__builtin_amdgcn_permlane32_swap(__float_as_uint(rm),__float_as_uint(rm),false,false); rm=__builtin_fmaxf(__uint_as_float(rr[0]),__uint_as_float(rr[1])); } \
      resc=false; \
      if(__builtin_expect(__any(rm>(float)THRL),0)){ const float dl=__builtin_fmaxf(rm,0.f); mhat+=dl; \
        _Pragma("unroll") for(int r=0;r<16;++r){C0[r]-=dl;C1[r]-=dl;} \
        _Pragma("unroll") for(int r=0;r<16;++r)negm[r]=-mhat; asm volatile("":"+v"(negm)); \
        const float f=__builtin_amdgcn_exp2f(-dl); l_reg*=f; if(hi==0)wsf[r32]=f; resc=true; } } \
    SBAR(); \
    GAPB(o[0]=__builtin_amdgcn_mfma_f32_32x32x16_bf16(PAF(0),VFR(0),o[0],0,0,0), C0,0); \
    GAPB(o[1]=__builtin_amdgcn_mfma_f32_32x32x16_bf16(PAF(0),VFR(4),o[1],0,0,0), C0,4); \
    KRD(GL,0); GAPB(o[0]=__builtin_amdgcn_mfma_f32_32x32x16_bf16(PAF(1),VFR(1),o[0],0,0,0), C0,8); \
    KRD(GL,1); GAPB(o[1]=__builtin_amdgcn_mfma_f32_32x32x16_bf16(PAF(1),VFR(5),o[1],0,0,0), C0,12); \
    KRD(GL,2); GAPB(o[0]=__builtin_amdgcn_mfma_f32_32x32x16_bf16(PAF(2),VFR(2),o[0],0,0,0), C1,0); \
    KRD(GL,3); GAPB(o[1]=__builtin_amdgcn_mfma_f32_32x32x16_bf16(PAF(2),VFR(6),o[1],0,0,0), C1,4); \
    GAPB(o[0]=__builtin_amdgcn_mfma_f32_32x32x16_bf16(PAF(3),VFR(3),o[0],0,0,0), C1,8); \
    GAPB(o[1]=__builtin_amdgcn_mfma_f32_32x32x16_bf16(PAF(3),VFR(7),o[1],0,0,0), C1,12); \
    }while(0)
  int t=1;
  #undef CMASK
  #define CMASK(P0,P1,t) do{}while(0)
  for(;t+5<NT;t+=2){
    STEP(pB0,pB1,pA0,pA1,t,true,true,true);     WAIT_BAR(2); RESC(); ROT();
    STEP(pA0,pA1,pB0,pB1,t+1,true,true,true);   WAIT_BAR(2); RESC(); ROT();
  }
  #undef CMASK
  #define CMASK(P0,P1,t) do{}while(0)
  #define ENDW(tt) do{ if((tt)+3<NT){WAIT_BAR(2);} else if((tt)+2<NT){WAIT_BAR(1);} else {WAIT_BAR(0);} }while(0)
  for(;t+1<NT;t+=2){
    STEP(pB0,pB1,pA0,pA1,t,(t+3<NT),(t+1<NT),(t+1<NT));       ENDW(t);   RESC(); ROT();
    STEP(pA0,pA1,pB0,pB1,t+1,(t+4<NT),(t+2<NT),(t+2<NT));     ENDW(t+1); RESC(); ROT();
  }
  if(has_next){ const bf16*ksn=n_Kh+(long)lane*KP+wid*8;
    glds16(ksn,(unsigned)__builtin_amdgcn_readfirstlane(kdst)); glds16(ksn+(long)KVBLK*KP,(unsigned)__builtin_amdgcn_readfirstlane(kdst+SLOTB)); glds16(ksn+(long)2*KVBLK*KP,(unsigned)__builtin_amdgcn_readfirstlane(kdst+2*SLOTB)); }
  STEP(pB0,pB1,pA0,pA1,NT-1,false,false,false);
  if(has_next){ const bf16*Qn=Q+(n_rowbase+n_qb*QB+wid*QBLK)*QP+n_h*D;
    _Pragma("unroll") for(int d0=0;d0<4;++d0)qr[d0]=*reinterpret_cast<const bf16x8*>(&Qn[(long)r32*QP+d0*16+hi*8]); }
  RESC();
  { float sacc=pB0[0]+pB0[1]; _Pragma("unroll") for(int r=2;r<16;++r)sacc+=pB0[r]; _Pragma("unroll") for(int r=0;r<16;++r)sacc+=pB1[r]; l_reg+=sacc;
    pw0=(u32x4){PKW(pB0,0),PKW(pB0,2),PKW(pB0,4),PKW(pB0,6)};pw1=(u32x4){PKW(pB0,8),PKW(pB0,10),PKW(pB0,12),PKW(pB0,14)};pw2=(u32x4){PKW(pB1,0),PKW(pB1,2),PKW(pB1,4),PKW(pB1,6)};pw3=(u32x4){PKW(pB1,8),PKW(pB1,10),PKW(pB1,12),PKW(pB1,14)};
    SBAR(); pv(o,vb0+sl_cur,PAF(0),PAF(1),PAF(2),PAF(3)); }
  #undef PKW
  #undef PAF
  #undef VFR
  #undef PIN
  #undef MX3
  #undef GAPA
  #undef GAPB
  #undef EX
  #undef VRD
  #undef KRD
  #undef STEP
  #undef ENDW
  {auto rr=__builtin_amdgcn_permlane32_swap(__float_as_uint(l_reg),__float_as_uint(l_reg),false,false);l_reg=__uint_as_float(rr[0])+__uint_as_float(rr[1]);}
  if(hi==0)wsf[32+r32]=l_reg;asm volatile("s_waitcnt lgkmcnt(0)":::"memory");
  float rli[16];
  #pragma unroll
  for(int r=0;r<16;++r)rli[r]=__builtin_amdgcn_rcpf(wsf[32+crow(r,hi)]);
  bf16*Ow=O+(rowbase+q0+wid*QBLK)*QP+h*D;
  { bf16*stg=(bf16*)(shm+LDS_OST)+wid*2048;
    #pragma unroll
    for(int r=0;r<16;++r){const int orow=crow(r,hi);
      #pragma unroll
      for(int d0=0;d0<2;++d0)stg[orow*64+d0*32+r32]=__float2bfloat16(o[d0][r]*rli[r]);}
    asm volatile("s_waitcnt lgkmcnt(0)":::"memory");
    #pragma unroll
    for(int i=0;i<4;++i){const int row=i*8+(lane>>3),ch=lane&7; const u32x4 v=*(const u32x4*)(stg+row*64+ch*8); ATTN_STORE16(Ow+(long)row*QP+ch*8,v);} }
  asm volatile("s_waitcnt lgkmcnt(0)\n\ts_barrier":::"memory");
  #undef DMA_K
  #undef DMA_V
  #undef CMASK
  #undef START
  #undef RESC
  #undef ROT
}
constexpr int ATTN_LDS_BYTES=LDS_BYTES;
#undef SBAR
#undef WAIT_BAR
}
constexpr int NWAVES = 8;
#ifndef MK_N_LAUNCHES
#define MK_N_LAUNCHES 1
#endif
#ifndef PROBE_PH
#define PROBE_PH -1
#endif
constexpr int N_LAUNCHES = MK_N_LAUNCHES;
constexpr int PER_PHASE = 6;

constexpr int D = 1024, FF = 4096, NIN = 1280, HD = 64;
constexpr int M = 49152;
constexpr int ROWS_P = 32768;
constexpr float EPS = 1e-6f;

constexpr size_t MiB = 1u << 20;
constexpr size_t WS_CTL = 0, CTL_ZERO_BYTES = 16384;
constexpr size_t WS_ROPE = 1 * MiB;
constexpr size_t WS_XINV = WS_ROPE + 65536;
constexpr size_t WS_STATS = 2 * MiB;
constexpr size_t WS_WIN = 6 * MiB, WS_WO = 9 * MiB, WS_WUP = 11 * MiB, WS_WDN = 19 * MiB;
constexpr size_t WS_XN = 32 * MiB;
constexpr size_t WS_MIX = 128 * MiB;
constexpr size_t WS_KV = 224 * MiB;
constexpr size_t WS_U = 248 * MiB;
constexpr size_t WS_H = 128 * MiB;
constexpr size_t WS_END = 512 * MiB;
static_assert(WS_WDN + (size_t)D * FF * 2 <= WS_XN && WS_XN + (size_t)M * D * 2 <= WS_MIX && WS_U + (size_t)M * 512 * 2 <= WS_END && WS_H + (size_t)M * FF * 2 <= WS_END && WS_STATS + (size_t)M * 64 <= WS_WIN, "d_ws map");

constexpr int RING_OFF = 0, RING_BYTES = 131072;
constexpr int LDSCTL_OFF = RING_BYTES, MISC_OFF = LDSCTL_OFF + 320;
constexpr int UPTAB_OFF = RING_BYTES + 2048;
constexpr int LDS_BYTES = 147456;
static_assert(UPTAB_OFF + 12 * 256 * 4 <= LDS_BYTES, "LDS map");

#define GAS __attribute__((address_space(1)))
#define LAS __attribute__((address_space(3)))
typedef unsigned short bf16;
typedef unsigned v4u __attribute__((ext_vector_type(4)));
typedef float f32x4 __attribute__((ext_vector_type(4)));
#define LDS_WAIT() asm volatile("s_waitcnt lgkmcnt(0)" ::: "memory")
__device__ __forceinline__ unsigned f2bf(float f) { unsigned u = __builtin_bit_cast(unsigned, f); return (u + 0x7fffu + ((u >> 16) & 1u)) >> 16; }
typedef float f32x2_pk __attribute__((ext_vector_type(2))); typedef __bf16 bf16x2_pk __attribute__((ext_vector_type(2)));
__device__ __forceinline__ unsigned pk2(float lo, float hi) { const f32x2_pk v = {lo, hi}; return __builtin_bit_cast(unsigned, __builtin_convertvector(v, bf16x2_pk)); }
__device__ __forceinline__ float bflo(unsigned w) { return __builtin_bit_cast(float, w << 16); }
__device__ __forceinline__ float bfhi(unsigned w) { return __builtin_bit_cast(float, w & 0xffff0000u); }

#define XB_TMO      128
#define XB_XCNT(j)  (256  + 64 * (j))
#define XB_XSUB(j)  (1280 + 64 * (j))
#define XB_XGEN(j)  (2304 + 64 * (j))
#define XB_TOP      3328
#define XB_TOPGEN   3392
#define XCD_BAR_WORDS 3456
#define XB_SPIN_CAP (1u << 18)

__device__ __forceinline__ unsigned xb_ld(unsigned* p)              { return __hip_atomic_load(p, __ATOMIC_RELAXED, __HIP_MEMORY_SCOPE_AGENT); }
__device__ __forceinline__ unsigned xb_add(unsigned* p, unsigned v) { return __hip_atomic_fetch_add(p, v, __ATOMIC_RELAXED, __HIP_MEMORY_SCOPE_AGENT); }
__device__ __forceinline__ unsigned xb_xcc_id() { return (unsigned)__builtin_amdgcn_s_getreg((3 << 11) | 20) & 0xFu; }
#define XB_SPIN(cond, bar) do { unsigned _sp = 0; while (cond) { __builtin_amdgcn_s_sleep(1); \
    if ((++_sp & 255u) == 0u) { if (xb_ld(&(bar)[XB_TMO])) break; if (_sp > XB_SPIN_CAP) { atomicAdd(&(bar)[XB_TMO], 1u); break; } } } } while (0)

struct XcdBarrier {
    unsigned* bar; unsigned x;
    volatile LAS unsigned* st;
};

__device__ __forceinline__ XcdBarrier xcd_barrier_post(unsigned* bar, volatile LAS unsigned* st) {
    XcdBarrier b; b.bar = bar; b.x = xb_xcc_id(); b.st = st;
    if (threadIdx.x == 0) (void)xb_add(&bar[XB_XCNT(b.x)], 1u);
    return b;
}
__device__ __forceinline__ void xcd_barrier_complete(unsigned* bar, unsigned x, unsigned& nloc, unsigned& nx) {
    const unsigned G = gridDim.x * gridDim.y * gridDim.z;
    unsigned sum, cnt, mine, sp = 0u;
    for (;;) {
        sum = 0u; cnt = 0u; mine = 0u;
#pragma unroll
        for (unsigned j = 0; j < 16; ++j) { const unsigned c = xb_ld(&bar[XB_XCNT(j)]); sum += c; cnt += (c > 0u) ? 1u : 0u; mine = (j == x) ? c : mine; }
        if (sum == G) break;
        __builtin_amdgcn_s_sleep(1);
        if ((++sp & 255u) == 0u) { if (xb_ld(&bar[XB_TMO])) break; if (sp > XB_SPIN_CAP) { atomicAdd(&bar[XB_TMO], 1u); break; } }
    }
    nloc = mine > 0u ? mine : 1u; nx = cnt > 0u ? cnt : 1u;
}

__device__ __forceinline__ void xcd_barrier(const XcdBarrier& b) {
    asm volatile("s_waitcnt vmcnt(0)" ::: "memory");
    __syncthreads();
    if (threadIdx.x == 0) {
        unsigned* bar = b.bar;
        __builtin_amdgcn_s_waitcnt(0);
        unsigned nloc = b.st[0], nx = b.st[1];
        if (nloc == 0u) { xcd_barrier_complete(bar, b.x, nloc, nx); b.st[0] = nloc; b.st[1] = nx; }
        const unsigned old = xb_add(&bar[XB_XSUB(b.x)], 1u);
        const unsigned gen = old / nloc;
        if (old + 1u == (gen + 1u) * nloc) {
            __builtin_amdgcn_fence(__ATOMIC_RELEASE, "agent");
            asm volatile("s_waitcnt vmcnt(0)" ::: "memory");
            const unsigned og = xb_add(&bar[XB_TOP], 1u);
            const unsigned tg = og / nx;
            if (og + 1u == (tg + 1u) * nx) xb_add(&bar[XB_TOPGEN], 1u);
            else XB_SPIN(xb_ld(&bar[XB_TOPGEN]) == tg, bar);
            __builtin_amdgcn_fence(__ATOMIC_ACQUIRE, "agent");
            xb_add(&bar[XB_XGEN(b.x)], 1u);
            asm volatile("s_waitcnt vmcnt(0)" ::: "memory");
        } else {
            XB_SPIN(xb_ld(&bar[XB_XGEN(b.x)]) == gen, bar);
            __builtin_amdgcn_fence(__ATOMIC_ACQUIRE, "agent");
            asm volatile("s_waitcnt vmcnt(0)" ::: "memory");
        }
    }
    __syncthreads();
}

struct Frame {
    LAS unsigned char* lds;
    int tid, lane, wave, vcu, G;
    const float *xp, *xs, *g1, *win, *qg, *kg, *wpool, *pscale, *wout, *g2, *wup, *wdn;
    float* out;
    bf16 *Win_t, *Wo_t, *Wup_t, *Wdn_t, *XN, *MIX, *KV, *U, *H;
    float *cosT, *sinT, *stats, *xinv;
};

__device__ __forceinline__ float wave_sum(float v) {
#pragma unroll
    for (int o = 1; o < 16; o <<= 1) v += __shfl_xor(v, o);
    v = pg8::xsum32(pg8::xsum16(v));
    return v;
}
__device__ __forceinline__ int inproj_dst_row(int A) {
    const int pn = A >> 8, a = A & 255;
    if (pn >= 3) return A;
    const int bj = (a >> 5) & 1, i = a & 31, head = a >> 6;
    int c;
    if (pn == 2 && a >= 128) c = 128 * bj + 32 * head + i;
    else c = 128 * bj + 32 * head + 8 * ((i >> 2) & 3) + 4 * (i >> 4) + (i & 3);
    return 256 * pn + c;
}
template <int MODE> __device__ __forceinline__ void p0_transpose_item(const float* W, int N, bf16* WT, int ldt, const float* kscale, LAS float* scr, int item, int lane) {
    const int nblk = N / 32, kb = item / nblk, nb = item % nblk, k0 = 64 * kb, n0 = 32 * nb;
#pragma unroll
    for (int i = 0; i < 32; ++i) { const int kk = 2 * i + (lane >> 5); float v = W[(size_t)(k0 + kk) * N + n0 + (lane & 31)]; if (kscale) v *= kscale[k0 + kk]; scr[kk * 33 + (lane & 31)] = v; }
    LDS_WAIT(); asm volatile("" ::: "memory");
    const int c = lane & 7;
#pragma unroll
    for (int j = 0; j < 4; ++j) { const int n = (lane >> 3) + 8 * j; const LAS float* s = scr + (8 * c) * 33 + n;
        v4u o; o.x = pk2(s[0 * 33], s[1 * 33]); o.y = pk2(s[2 * 33], s[3 * 33]); o.z = pk2(s[4 * 33], s[5 * 33]); o.w = pk2(s[6 * 33], s[7 * 33]);
        const int dr = MODE == 1 ? inproj_dst_row(n0 + n) : (n0 + n);
        *(GAS v4u*)(WT + (size_t)dr * ldt + k0 + 8 * c) = o; }
    LDS_WAIT(); asm volatile("" ::: "memory");
}
__device__ __forceinline__ void titem_load(const float* tW, int tN, int tr, int lane, float (&v)[32]) {
    const int nblk = tN / 32, kb = tr / nblk, nb = tr % nblk, k0 = 64 * kb, n0 = 32 * nb;
#pragma unroll
    for (int i = 0; i < 32; ++i) { const int kk = 2 * i + (lane >> 5); v[i] = tW[(size_t)(k0 + kk) * tN + n0 + (lane & 31)]; }
}
__device__ __forceinline__ void titem_store(int tN, bf16* tWT, int tldt, const float* tks, int tmode, int tr, LAS float* scr, int lane, const float (&v)[32]) {
    const int nblk = tN / 32, kb = tr / nblk, nb = tr % nblk, k0 = 64 * kb, n0 = 32 * nb;
#pragma unroll
    for (int i = 0; i < 32; ++i) { const int kk = 2 * i + (lane >> 5); float x = v[i]; if (tks) x *= tks[k0 + kk]; scr[kk * 33 + (lane & 31)] = x; }
    LDS_WAIT(); asm volatile("" ::: "memory");
    const int c = lane & 7;
#pragma unroll
    for (int j = 0; j < 4; ++j) { const int n = (lane >> 3) + 8 * j; const LAS float* sp = scr + (8 * c) * 33 + n;
        v4u o; o.x = pk2(sp[0 * 33], sp[1 * 33]); o.y = pk2(sp[2 * 33], sp[3 * 33]); o.z = pk2(sp[4 * 33], sp[5 * 33]); o.w = pk2(sp[6 * 33], sp[7 * 33]);
        const int dr = tmode == 1 ? inproj_dst_row(n0 + n) : (n0 + n);
        *(GAS v4u*)(tWT + (size_t)dr * tldt + k0 + 8 * c) = o; }
    LDS_WAIT(); asm volatile("" ::: "memory");
}
__device__ __forceinline__ void rms_row_to_bf16(Frame& F, const f32x4 (&v)[4], bf16* orow, float* xinv_row) {
    const GAS f32x4* gr = (const GAS f32x4*)F.g1 + 2 * F.lane;
    float s = 0.f;
#pragma unroll
    for (int j = 0; j < 4; ++j) { s += (v[j].x * v[j].x + v[j].y * v[j].y) + (v[j].z * v[j].z + v[j].w * v[j].w); }
    const float ms = wave_sum(s) * (1.f / D) + EPS, rstd = __builtin_amdgcn_rsqf(ms), rms = ms * rstd;
    if (F.lane == 0) *xinv_row = rms;
    GAS v4u* o16 = (GAS v4u*)orow + F.lane;
#pragma unroll
    for (int j = 0; j < 2; ++j) { const f32x4 ga = gr[128 * j], gb = gr[128 * j + 1]; const f32x4 ya = v[2 * j] * rstd * ga, yb = v[2 * j + 1] * rstd * gb;
        v4u o; o.x = pk2(ya.x, ya.y); o.y = pk2(ya.z, ya.w); o.z = pk2(yb.x, yb.y); o.w = pk2(yb.z, yb.w); o16[64 * j] = o; }
}
constexpr int P0_WW = 2;
__device__ __forceinline__ void p0_prologue(Frame& F) {
    LAS float* scr = (LAS float*)(F.lds + RING_OFF + F.wave * 16384);
    if (F.wave < P0_WW) {
    const int gw = F.vcu * P0_WW + F.wave, NGW = F.G * P0_WW;
    const int gt = gw * 64 + F.lane, NGT = NGW * 64;
    for (int it = gt; it < 2048; it += NGT) {
        const int pos = it >> 4, f = it & 15; double invf = 1.0;
        for (int i = 0; i < f; ++i) invf *= 0.5623413251903491;
        const double a = (double)pos * invf, k = __builtin_rint(a * 0.15915494309189535), r = a - k * 6.283185307179586, r2 = r * r;
        double s = 1.0, c = 1.0;
        for (int i = 16; i >= 1; --i) { s = 1.0 - s * r2 / (double)((2 * i) * (2 * i + 1)); c = 1.0 - c * r2 / (double)((2 * i - 1) * (2 * i)); }
        s *= r; F.cosT[it] = (float)c; F.sinT[it] = (float)s;
    }
    for (int it = gt; it < 128 * 1024; it += NGT) {
        const int jb = __builtin_amdgcn_readfirstlane(it >> 10), n = it & 1023, g = jb >> 5, jj0 = (jb & 31) * 4;
        const float* wp = F.wpool + ((size_t)g * 128 + jj0) * 128; const float* ps = F.pscale + g * 128; const float* wo = F.wout + (size_t)(512 + g * 128) * 1024 + n;
        float a0 = 0.f, a1 = 0.f, a2 = 0.f, a3 = 0.f;
        for (int e0 = 0; e0 < 128; e0 += 32) { float w[32];
#pragma unroll
            for (int i = 0; i < 32; ++i) w[i] = wo[(size_t)(e0 + i) * 1024];
#pragma unroll
            for (int i = 0; i < 32; ++i) { const float ww = w[i] * ps[e0 + i]; a0 += wp[0 * 128 + e0 + i] * ww; a1 += wp[1 * 128 + e0 + i] * ww; a2 += wp[2 * 128 + e0 + i] * ww; a3 += wp[3 * 128 + e0 + i] * ww; } }
        typedef unsigned v2u __attribute__((ext_vector_type(2)));
        v2u o; o.x = pk2(a0, a1); o.y = pk2(a2, a3);
        *(GAS v2u*)(F.Wo_t + (size_t)n * 1024 + 512 + jb * 4) = o;
    }
    constexpr int I_IN = (D / 64) * (NIN / 32), I_O = (512 / 64) * (D / 32), I_UP = (D / 64) * (FF / 32), I_DN = (FF / 64) * (D / 32);
    constexpr int NITEMS = I_IN + I_O + I_UP + I_DN;
#define P0_DECODE(p, it_) const float* p##W; int p##N; bf16* p##WT; int p##ldt; const float* p##ks; int p##mode; int p##r; { int r_ = (it_); \
        if (r_ < I_IN) { p##W = F.win; p##N = NIN; p##WT = F.Win_t; p##ldt = D; p##ks = nullptr; p##mode = 1; p##r = r_; } \
        else if (r_ < I_IN + I_O) { p##W = F.wout; p##N = D; p##WT = F.Wo_t; p##ldt = D; p##ks = nullptr; p##mode = 0; p##r = r_ - I_IN; } \
        else if (r_ < I_IN + I_O + I_UP) { p##W = F.wup; p##N = FF; p##WT = F.Wup_t; p##ldt = D; p##ks = F.g2; p##mode = 0; p##r = r_ - I_IN - I_O; } \
        else { p##W = F.wdn; p##N = D; p##WT = F.Wdn_t; p##ldt = FF; p##ks = nullptr; p##mode = 0; p##r = r_ - I_IN - I_O - I_UP; } }
    for (int it = gw; it < NITEMS; it += 2 * NGW) {
        const int it2 = it + NGW; const bool two = it2 < NITEMS;
        P0_DECODE(ta, it) P0_DECODE(tb, two ? it2 : it)
        float va[32], vb[32];
        titem_load(taW, taN, tar, F.lane, va); titem_load(tbW, tbN, tbr, F.lane, vb);
        titem_store(taN, taWT, taldt, taks, tamode, tar, scr, F.lane, va); if (two) titem_store(tbN, tbWT, tbldt, tbks, tbmode, tbr, scr, F.lane, vb);
    }
#undef P0_DECODE
    } else {
    const int gw = F.vcu * (NWAVES - P0_WW) + (F.wave - P0_WW), NGW = F.G * (NWAVES - P0_WW);
    for (int m = gw; m < M; m += 4 * NGW) {
        f32x4 v[4][4];
#pragma unroll
        for (int q = 0; q < 4; ++q) { const int mm = m + q * NGW; if (mm < M) { const float* xrow = mm < ROWS_P ? F.xp + (size_t)mm * D : F.xs + (size_t)(mm - ROWS_P) * D; const GAS f32x4* xr = (const GAS f32x4*)xrow + 2 * F.lane;
#pragma unroll
            for (int j = 0; j < 2; ++j) { v[q][2 * j] = xr[128 * j]; v[q][2 * j + 1] = xr[128 * j + 1]; } } else {
#pragma unroll
            for (int j = 0; j < 4; ++j) v[q][j] = (f32x4){0.f, 0.f, 0.f, 0.f}; } }
#pragma unroll
        for (int q = 0; q < 4; ++q) { const int mm = m + q * NGW; if (mm < M) rms_row_to_bf16(F, v[q], F.XN + (size_t)mm * D, F.xinv + mm); }
    }
    }
}

template <int HW> struct PoolItem {
    v4u w[8 + 2 * HW]; int S, t0, seq0, cc;
    __device__ __forceinline__ void load(Frame& F, int g, int rg, int lane) {
        const int row0 = rg * 32 + (lane >> 4) * 8; cc = g * 16 + (lane & 15);
        if (row0 < ROWS_P) { S = 4096; t0 = row0 & 4095; } else { S = 8192; t0 = (row0 - ROWS_P) & 8191; }
        seq0 = row0 - t0;
        const GAS v4u* ub = (const GAS v4u*)(F.U + (size_t)seq0 * 512 + cc * 8);
#pragma unroll
        for (int k = 0; k < 8 + 2 * HW; ++k) { const int j = t0 - HW + k; w[k] = (j >= 0 && j < S) ? ub[(size_t)j * 64] : (v4u){0u, 0u, 0u, 0u}; }
    }
    __device__ __forceinline__ void finish(Frame& F) {
        float s0 = 0.f, s1 = 0.f, s2 = 0.f, s3 = 0.f, s4 = 0.f, s5 = 0.f, s6 = 0.f, s7 = 0.f;
#pragma unroll
        for (int k = 0; k < 2 * HW; ++k) { s0 += bflo(w[k].x); s1 += bfhi(w[k].x); s2 += bflo(w[k].y); s3 += bfhi(w[k].y); s4 += bflo(w[k].z); s5 += bfhi(w[k].z); s6 += bflo(w[k].w); s7 += bfhi(w[k].w); }
#pragma unroll
        for (int r = 0; r < 8; ++r) {
            const int t = t0 + r, lo = t - HW < 0 ? 0 : t - HW, hi = t + HW > S ? S : t + HW; const float inv = __builtin_amdgcn_rcpf((float)(hi - lo));
            const v4u c = w[r + HW];
            v4u o; o.x = pk2(s0 * inv - bflo(c.x), s1 * inv - bfhi(c.x)); o.y = pk2(s2 * inv - bflo(c.y), s3 * inv - bfhi(c.y)); o.z = pk2(s4 * inv - bflo(c.z), s5 * inv - bfhi(c.z)); o.w = pk2(s6 * inv - bflo(c.w), s7 * inv - bfhi(c.w));
            *(GAS v4u*)(F.MIX + (size_t)(seq0 + t) * 1024 + 512 + cc * 8) = o;
            if (r < 7) { const v4u a = w[r + 2 * HW], b = w[r];
                s0 += bflo(a.x) - bflo(b.x); s1 += bfhi(a.x) - bfhi(b.x); s2 += bflo(a.y) - bflo(b.y); s3 += bfhi(a.y) - bfhi(b.y); s4 += bflo(a.z) - bflo(b.z); s5 += bfhi(a.z) - bfhi(b.z); s6 += bflo(a.w) - bflo(b.w); s7 += bfhi(a.w) - bfhi(b.w); }
        }
    }
};
template <int HW> __device__ __forceinline__ void pool_wave(Frame& F, int g, int first, int stride) {
    constexpr int NRG = M / 32;
    if (HW <= 4 && first + 2 * stride < NRG && first + 3 * stride >= NRG) {
        PoolItem<HW> a, b; a.load(F, g, first, F.lane); b.load(F, g, first + stride, F.lane);
        a.finish(F); a.load(F, g, first + 2 * stride, F.lane); b.finish(F); a.finish(F);
    } else {
        for (int rg = first; rg < NRG; rg += stride) { PoolItem<HW> a; a.load(F, g, rg, F.lane); a.finish(F); }
    }
}
__device__ __forceinline__ void pool_role_big(Frame& F, int idx) { constexpr int NRG = M / 32;
    { PoolItem<8> a; a.load(F, 3, idx, F.lane); a.finish(F); }
    { PoolItem<8> b; b.load(F, 3, idx + NRG / 2, F.lane); b.finish(F); } }
__device__ __forceinline__ void pool_role_mid(Frame& F, int idx) { constexpr int NRG = M / 32;
    PoolItem<4> a, b, c; a.load(F, 2, idx, F.lane); b.load(F, 2, idx + NRG / 3, F.lane); a.finish(F); c.load(F, 2, idx + 2 * (NRG / 3), F.lane); b.finish(F); c.finish(F); }
__device__ __forceinline__ void pool_role_small(Frame& F, int idx) { constexpr int NRG = M / 32;
    PoolItem<2> a1, b1; PoolItem<1> a0, b0;
    a1.load(F, 1, idx, F.lane); b1.load(F, 1, idx + NRG / 2, F.lane); a1.finish(F); a0.load(F, 0, idx, F.lane); b1.finish(F); b0.load(F, 0, idx + NRG / 2, F.lane); a0.finish(F); b0.finish(F); }
__device__ __forceinline__ void pool_pass(Frame& F) {
    if (F.G == 256) {
        const int w = F.wave;
        if (w < 3) pool_role_big(F, F.vcu * 3 + w); else if (w < 5) pool_role_mid(F, F.vcu * 2 + (w - 3)); else pool_role_small(F, F.vcu * 3 + (w - 5));
        return;
    }
    const int gw = F.vcu * NWAVES + F.wave, NGW = F.G * NWAVES;
    const int g = gw & 3, first = gw >> 2, stride = NGW >> 2;
    if (g == 0) pool_wave<1>(F, 0, first, stride); else if (g == 1) pool_wave<2>(F, 1, first, stride); else if (g == 2) pool_wave<4>(F, 2, first, stride); else pool_wave<8>(F, 3, first, stride);
}

__device__ __forceinline__ void attn_decode(int L, long& rowbase, int& NT, int& h, int& qb, int& kvh) {
    const int i = L >> 8, v = L & 255, xcd = v >> 5, l = v & 31;
    if (i < 4) { const int combo = xcd * 2 + (i >> 1), b = combo >> 1; kvh = combo & 1; const int idx = (i & 1) * 32 + l; h = kvh * 4 + (idx >> 4); qb = idx & 15; rowbase = (long)b * 4096; NT = 64; }
    else { const int combo = xcd >> 1, b = combo >> 1; kvh = combo & 1; const int idx = (xcd & 1) * 64 + (i - 4) * 32 + l; h = kvh * 4 + (idx >> 5); qb = idx & 31; rowbase = (long)ROWS_P + (long)b * 8192; NT = 128; }
}
template <bool NOMAX> __device__ __forceinline__ void attn_all_t(Frame& F, char* lds, bf16* Obuf) {
    attn_body::bf16x8 qr[4] = {};
    bool first = true;
    for (int L = F.vcu; L < 1536; L += F.G) {
        long rowbase, n_rowbase; int NT, h, qb, kvh, n_NT, n_h, n_qb, n_kvh;
        attn_decode(L, rowbase, NT, h, qb, kvh);
        const bool has_next = L + F.G < 1536;
        attn_decode(has_next ? L + F.G : L, n_rowbase, n_NT, n_h, n_qb, n_kvh);
        const attn_body::bf16* Kh = (const attn_body::bf16*)F.KV + rowbase * 256 + kvh * 64;
        const attn_body::bf16* n_Kh = (const attn_body::bf16*)F.KV + n_rowbase * 256 + n_kvh * 64;
        attn_body::attn_unit<8, NOMAX>(rowbase, NT, h, qb, (const attn_body::bf16*)F.MIX, Kh, Kh + 128, (attn_body::bf16*)Obuf, lds, first, has_next, n_rowbase, n_h, n_qb, n_Kh, qr);
        first = false;
    }
}
__device__ __forceinline__ void attn_all(Frame& F, char* lds, bf16* Obuf) {
    float mq = 0.f, mk = 0.f;
    for (int i = 0; i < 64; ++i) { mq = fmaxf(mq, fabsf(F.qg[i])); mk = fmaxf(mk, fabsf(F.kg[i])); }
    const bool fast = 2.0f * (8.0f * 1.4426950408889634f) * mq * mk < 64.0f;
    if (fast) attn_all_t<true>(F, lds, Obuf); else attn_all_t<false>(F, lds, Obuf);
}

struct Args { const float* in[12]; float* out; unsigned char* ws; int ph_lo, ph_hi; };
__global__ void __launch_bounds__(NWAVES * 64, 2) mega_fwd(Args args) {
    extern __shared__ __attribute__((aligned(16))) unsigned char lds[];
    Frame F;
    F.lds = (LAS unsigned char*)lds;
    F.tid = threadIdx.x; F.lane = F.tid & 63; F.wave = __builtin_amdgcn_readfirstlane(F.tid >> 6);
    F.G = gridDim.x; { const int bx = blockIdx.x; F.vcu = (F.G % 8 == 0) ? (bx % 8) * (F.G / 8) + bx / 8 : bx; }
    unsigned char* ws = args.ws;
    F.xp = args.in[0]; F.xs = args.in[1]; F.g1 = args.in[2]; F.win = args.in[3]; F.qg = args.in[4]; F.kg = args.in[5]; F.wpool = args.in[6]; F.pscale = args.in[7];
    F.wout = args.in[8]; F.g2 = args.in[9]; F.wup = args.in[10]; F.wdn = args.in[11]; F.out = args.out;
    F.Win_t = (bf16*)(ws + WS_WIN); F.Wo_t = (bf16*)(ws + WS_WO); F.Wup_t = (bf16*)(ws + WS_WUP); F.Wdn_t = (bf16*)(ws + WS_WDN);
    F.XN = (bf16*)(ws + WS_XN); F.MIX = (bf16*)(ws + WS_MIX); F.KV = (bf16*)(ws + WS_KV); F.U = (bf16*)(ws + WS_U); F.H = (bf16*)(ws + WS_H);
    F.cosT = (float*)(ws + WS_ROPE); F.sinT = F.cosT + 2048; F.stats = (float*)(ws + WS_STATS); F.xinv = (float*)(ws + WS_XINV);
#if MK_N_LAUNCHES == 1
    cg::grid_group grid = cg::this_grid();
    for (int u = F.tid; u < (LDS_BYTES - LDSCTL_OFF) / 4; u += NWAVES * 64) ((LAS unsigned*)(F.lds + LDSCTL_OFF))[u] = 0u;
    __syncthreads();
    XcdBarrier bar = xcd_barrier_post((unsigned*)(ws + WS_CTL), (volatile LAS unsigned*)(F.lds + MISC_OFF) + 8);
#define GRID_BAR() do { if (args.ph_hi < 0) { asm volatile("s_waitcnt vmcnt(0)" ::: "memory"); grid.sync(); } else xcd_barrier(bar); } while (0)
#define GRID_BAR0() GRID_BAR()
#else
#define GRID_BAR0() do {} while (0)
#define GRID_BAR() do {} while (0)
#endif
    const int lo = args.ph_lo, hi = args.ph_hi < 0 ? -args.ph_hi : args.ph_hi;
#define IN(k) (lo <= (k) && (k) < hi)
#define BOTH(k) (IN(k) && IN((k) + 1))
    if (IN(0)) { p0_prologue(F);
#if PROBE_PH == 0
        p0_prologue(F);
#endif
        if (BOTH(0)) GRID_BAR0(); }
    if (IN(1)) {
        pg8::Gemm g{F.XN, F.Win_t, M, NIN, D}; pg8::StaticOrder S; S.init(M, NIN, F.G, (int)blockIdx.x);
        pg8::EpiInProj E{F.MIX, F.KV, F.U, F.qg, F.kg, F.cosT, F.sinT};
        pg8::gemm_phase<pg8::EpiInProj, pg8::StaticOrder, PG8_ALIGN, PG8_SP2>(F.lds + RING_OFF, g, S, E);
#if PROBE_PH == 1
        pg8::gemm_phase<pg8::EpiInProj, pg8::StaticOrder, PG8_ALIGN, PG8_SP2>(F.lds + RING_OFF, g, S, E);
#endif
        if (BOTH(1)) GRID_BAR();
    }
    if (IN(2)) {
        static_assert(attn_body::ATTN_LDS_BYTES <= RING_BYTES, "attention LDS");
        pool_pass(F);
#if PROBE_PH == 2
        attn_all(F, (char*)lds + RING_OFF, F.XN);
#endif
#if PROBE_PH == 7
        pool_pass(F);
#endif
        attn_all(F, (char*)lds + RING_OFF, F.MIX);
        if (BOTH(2)) GRID_BAR();
    }
    if (IN(3)) {
        pg8::Gemm g{F.MIX, F.Wo_t, M, D, D}; pg8::StaticOrder S; S.init(M, D, F.G, (int)blockIdx.x);
        const int g_ok = __syncthreads_and((fabsf(F.g1[F.tid]) >= 1e-3f && fabsf(F.g1[F.tid + 512]) >= 1e-3f) ? 1 : 0);
        if (g_ok) { pg8::EpiResStats<true> E{F.xp, F.xs, F.XN, F.stats, F.xinv, F.g1};
            pg8::gemm_phase<pg8::EpiResStats<true>, pg8::StaticOrder, PG8_ALIGN, PG8_SP2>(F.lds + RING_OFF, g, S, E); }
        else { pg8::EpiResStats<false> E{F.xp, F.xs, F.XN, F.stats, F.xinv, F.g1};
            pg8::gemm_phase<pg8::EpiResStats<false>, pg8::StaticOrder, PG8_ALIGN, PG8_SP2>(F.lds + RING_OFF, g, S, E); }
        if (BOTH(3)) GRID_BAR();
    }
    if (IN(4)) {
        pg8::Gemm g{F.XN, F.Wup_t, M, FF, D}; pg8::StaticOrder S; S.init(M, FF, F.G, (int)blockIdx.x);
        LAS float* tab = (LAS float*)(F.lds + UPTAB_OFF);
        { const int rowi = F.tid & 255;
          for (int i = F.tid >> 8; i < pg8::UP_TAB_ROUNDS; i += 2) { const int pm = S.pm_at(i); if (pm < 0) break;
              const f32x4* p = (const f32x4*)(F.stats + (size_t)(pm * 256 + rowi) * 16); const f32x4 a = p[0], b = p[1], c = p[2], d = p[3];
              const float ssum = ((a[0] + a[1]) + (a[2] + a[3])) + ((b[0] + b[1]) + (b[2] + b[3])) + ((c[0] + c[1]) + (c[2] + c[3])) + ((d[0] + d[1]) + (d[2] + d[3]));
              tab[i * 256 + rowi] = __builtin_amdgcn_rsqf(ssum * (1.0f / 1024.0f) + EPS); }
          __syncthreads(); }
        pg8::EpiUp E{F.H, F.stats, tab};
        pg8::gemm_phase<pg8::EpiUp, pg8::StaticOrder, PG8_ALIGN, PG8_SP2>(F.lds + RING_OFF, g, S, E);
#if PROBE_PH == 4
        pg8::gemm_phase<pg8::EpiUp, pg8::StaticOrder, PG8_ALIGN, PG8_SP2>(F.lds + RING_OFF, g, S, E);
#endif
        if (BOTH(4)) GRID_BAR();
    }
    if (IN(5)) {
        pg8::Gemm g{F.H, F.Wdn_t, M, D, FF}; pg8::StaticOrder S; S.init(M, D, F.G, (int)blockIdx.x, 1);
        pg8::EpiDown E{F.out, F.XN};
        pg8::gemm_phase<pg8::EpiDown, pg8::StaticOrder, PG8_ALIGN, PG8_SP2>(F.lds + RING_OFF, g, S, E);
#if PROBE_PH == 5
        pg8::gemm_phase<pg8::EpiDown, pg8::StaticOrder, PG8_ALIGN, PG8_SP2>(F.lds + RING_OFF, g, S, E);
#endif
    }
#undef IN
#undef BOTH
}

extern "C" void kernel_launch(void* const* d_in, const int* in_sizes, int n_in, void* d_out, int out_size, void* d_ws, size_t ws_size, hipStream_t stream) {
    static int grid = 0;
    if (grid == 0) {
        if (n_in != 12 || in_sizes[0] != ROWS_P * D || in_sizes[1] != (M - ROWS_P) * D || out_size != M * D || ws_size < WS_END) {
            fprintf(stderr, "kernel_launch: shape / workspace mismatch (n_in %d, out %d, ws %zu < %zu); nothing launched\n", n_in, out_size, ws_size, (size_t)WS_END); grid = -1; return; }
        int dev = 0, cus = 0, per_cu = 0;
        if (hipGetDevice(&dev) != hipSuccess || hipDeviceGetAttribute(&cus, hipDeviceAttributeMultiprocessorCount, dev) != hipSuccess) { grid = -1; return; }
        if (hipFuncSetAttribute((const void*)mega_fwd, hipFuncAttributeMaxDynamicSharedMemorySize, LDS_BYTES) != hipSuccess) { fprintf(stderr, "kernel_launch: hipFuncSetAttribute failed\n"); grid = -1; return; }
        if (hipOccupancyMaxActiveBlocksPerMultiprocessor(&per_cu, (const void*)mega_fwd, NWAVES * 64, LDS_BYTES) != hipSuccess || per_cu < 1) { fprintf(stderr, "kernel_launch: occupancy query says %d\n", per_cu); per_cu = 1; }
        (void)hipGetLastError();
        grid = cus * per_cu;
    }
    if (grid < 0) return;
    Args a{};
    for (int i = 0; i < 12; ++i) a.in[i] = (const float*)d_in[i];
    a.out = (float*)d_out; a.ws = (unsigned char*)d_ws;
#if MK_N_LAUNCHES == 1
    a.ph_lo = 0; a.ph_hi = PER_PHASE;
    if (hipMemsetAsync((char*)d_ws + WS_CTL, 0, CTL_ZERO_BYTES, stream) != hipSuccess) { fprintf(stderr, "kernel_launch: memset of the barrier words failed\n"); return; }
    void* kargs[] = {&a};
    hipError_t e = hipLaunchCooperativeKernel((const void*)mega_fwd, dim3(grid), dim3(NWAVES * 64), kargs, LDS_BYTES, stream);
    if (e != hipSuccess) fprintf(stderr, "kernel_launch: cooperative launch failed: %s (grid %d)\n", hipGetErrorString(e), grid);
#else
    for (int li = 0; li < PER_PHASE; ++li) { a.ph_lo = li; a.ph_hi = li + 1; hipLaunchKernelGGL(mega_fwd, dim3(grid), dim3(NWAVES * 64), LDS_BYTES, stream, a); }
#endif
}
```

```cpp
#define MK_N_LAUNCHES 1
#include <hip/hip_runtime.h>
#include <hip/hip_cooperative_groups.h>
#include <cstdio>
#include <cstdint>
namespace cg = cooperative_groups;
namespace pg8 {
#define PG8_LAS __attribute__((address_space(3)))
typedef unsigned short bf16_t;
typedef short bf16x8 __attribute__((ext_vector_type(8)));
typedef float f32x4 __attribute__((ext_vector_type(4)));
typedef unsigned u32x4 __attribute__((ext_vector_type(4)));
constexpr int BM = 256, BK = 64, HALF = 128, HTB = HALF * BK * 2  , STAGE_BYTES = 8 * HTB, NXCD = 8, WGM = 8;

__host__ __device__ __forceinline__ int lds_byte(int r, int c) { const int st = (r >> 4) * 2 + (c >> 5), rr = r & 15, cc = c & 31, ob = rr * 64 + cc * 2; return st * 1024 + (ob ^ (((ob >> 9) & 1) << 5)); }
__host__ __device__ __forceinline__ void stage_rc(int b, int& R, int& C) { const int st = b / 1024, sb = b % 1024, swz = sb ^ (((sb >> 9) & 1) << 5); R = (st >> 1) * 16 + swz / 64; C = (st & 1) * 32 + (swz % 64) / 2; }
__host__ __device__ __forceinline__ int perm32(int rho) { const int n = rho >> 4, i = rho & 15; return 8 * (i >> 2) + 4 * n + (i & 3); }

struct Unit { int pm, pn, idx; };
struct Gemm { const bf16_t* A; const bf16_t* Bt; int M, N, K; };

struct StaticOrder {
    int nM, nN, nwg, G, c, R, rev;
    __host__ __device__ void init(int M, int N, int G_, int c_, int rev_ = 0) { nM = M / BM; nN = N / BM; nwg = nM * nN; G = G_; c = c_; R = (nwg + G - 1) / G; rev = rev_; }
    __host__ __device__ bool next(int i, Unit& u) const {
        if (i >= R) return false;
        const long L = (long)(rev ? R - 1 - i : i) * G + c; if (L >= nwg) return false;
        int wgid = (int)L; { const int q = nwg / NXCD, r = nwg % NXCD, xcd = wgid % NXCD, off = wgid / NXCD; wgid = (xcd < r ? xcd * (q + 1) : r * (q + 1) + (xcd - r) * q) + off; }
        const int nig = WGM * nN, gid = wgid / nig, fm = gid * WGM, gsz = (nM - fm) < WGM ? (nM - fm) : WGM;
        u.pm = fm + ((wgid % nig) % gsz); u.pn = (wgid % nig) / gsz; u.idx = i; return true;
    }
    __device__ __forceinline__ int pm_at(int i) const {
        if (i >= R) return -1;
        const long L = (long)(rev ? R - 1 - i : i) * G + c; if (L >= nwg) return -1;
        int wgid = (int)L; { const int q = nwg / NXCD, r = nwg % NXCD, xcd = wgid % NXCD, off = wgid / NXCD; wgid = (xcd < r ? xcd * (q + 1) : r * (q + 1) + (xcd - r) * q) + off; }
        const int nig = WGM * nN, gid = wgid / nig, fm = gid * WGM, gsz = (nM - fm) < WGM ? (nM - fm) : WGM;
        return fm + ((wgid % nig) % gsz);
    }
    __device__ __forceinline__ void a_ready(const Unit&) const {}
    __device__ __forceinline__ void done(const Unit&) const {}
};

__device__ __forceinline__ unsigned cvt_pk_bf16(float lo, float hi) { unsigned r; asm volatile("v_cvt_pk_bf16_f32 %0, %1, %2" : "=v"(r) : "v"(lo), "v"(hi)); return r; }

typedef float f32x2 __attribute__((ext_vector_type(2)));
typedef unsigned u32x2 __attribute__((ext_vector_type(2)));
constexpr int ROWS_PROMPT = 8 * 4096;
constexpr float RMS_EPS = 1e-6f;
constexpr float QK_C2 = 0.125f * 1.4426950408889634f;

struct EpiInProj {
    static constexpr bool PERM = true, AFTER_DRAIN = false;
    bf16_t* MIX; bf16_t* KV; bf16_t* U; const float* qg; const float* kg; const float* cosT; const float* sinT;
    __device__ __forceinline__ void operator()(const f32x4 (&acc)[2][2][4][2], const Unit& u, int wr, int wc, int fr, int fq) const {
        const int row0 = u.pm * BM + wr * 64 + fr;
        if (u.pn >= 3 || (u.pn == 2 && wc >= 2)) {
            bf16_t* base; int pitch;
            if (u.pn >= 3) { base = U + (size_t)row0 * 512 + (u.pn - 3) * 256 + wc * 32 + 8 * fq; pitch = 512; }
            else { base = KV + (size_t)row0 * 256 + 128 + (wc - 2) * 64 + 8 * fq; pitch = 256; }
            const int bjs = (u.pn >= 3) ? HALF : 32;
#pragma unroll
            for (int ai = 0; ai < 2; ++ai)
#pragma unroll
                for (int m = 0; m < 4; ++m) { bf16_t* rowp = base + (size_t)(ai * HALF + m * 16) * pitch;
#pragma unroll
                    for (int bj = 0; bj < 2; ++bj) { const f32x4 v0 = acc[ai][bj][m][0], v1 = acc[ai][bj][m][1];
                        u32x4 w; w.x = cvt_pk_bf16(v0[0], v0[1]); w.y = cvt_pk_bf16(v0[2], v0[3]); w.z = cvt_pk_bf16(v1[0], v1[1]); w.w = cvt_pk_bf16(v1[2], v1[3]);
                        *(u32x4*)(rowp + bj * bjs) = w; } }
            return;
        }
        const bool isK = (u.pn == 2);
        const float* g = isK ? kg : qg; const float sc = isK ? 1.f : QK_C2;
        bf16_t* base; int pitch;
        if (isK) { base = KV + (size_t)row0 * 256 + wc * 64 + 8 * fq; pitch = 256; } else { base = MIX + (size_t)row0 * 1024 + (u.pn * 4 + wc) * 64 + 8 * fq; pitch = 1024; }
        f32x4 gv[2][2];
#pragma unroll
        for (int bj = 0; bj < 2; ++bj)
#pragma unroll
            for (int n = 0; n < 2; ++n) gv[bj][n] = *(const f32x4*)(g + 32 * bj + 16 * n + 4 * fq) * sc;
        const int rowt = u.pm * BM; const int t0 = rowt < ROWS_PROMPT ? (rowt & 4095) : ((rowt - ROWS_PROMPT) & 8191);
        const int prow_base = (t0 >> 6) + wr;
#pragma unroll
        for (int ai = 0; ai < 2; ++ai) {
            const int prow = prow_base + 2 * ai;
            const f32x4 cr = *(const f32x4*)(cosT + prow * 16 + 4 * fq), sr = *(const f32x4*)(sinT + prow * 16 + 4 * fq);
#pragma unroll
            for (int m = 0; m < 4; ++m) {
                const int pcol = 16 * m + fr;
                const f32x4 cc = *(const f32x4*)(cosT + pcol * 16 + 4 * fq), sn = *(const f32x4*)(sinT + pcol * 16 + 4 * fq);
                float ss = 0.f;
#pragma unroll
                for (int bj = 0; bj < 2; ++bj)
#pragma unroll
                    for (int n = 0; n < 2; ++n) { const f32x4 x = acc[ai][bj][m][n]; ss += (x[0] * x[0] + x[1] * x[1]) + (x[2] * x[2] + x[3] * x[3]); }
                ss += __shfl_xor(ss, 16); ss += __shfl_xor(ss, 32);
                const float rstd = __builtin_amdgcn_rsqf(ss * (1.0f / 64.0f) + RMS_EPS);
                bf16_t* rowp = base + (size_t)(ai * HALF + m * 16) * pitch;
#pragma unroll
                for (int bj = 0; bj < 2; ++bj) { const f32x4 c = bj == 0 ? cr : cc, s = bj == 0 ? sr : sn;
                    const f32x4 y0 = acc[ai][bj][m][0] * rstd * gv[bj][0], y1 = acc[ai][bj][m][1] * rstd * gv[bj][1];
                    const f32x4 o0 = y0 * c - y1 * s, o1 = y1 * c + y0 * s;
                    u32x4 w; w.x = cvt_pk_bf16(o0[0], o0[1]); w.y = cvt_pk_bf16(o0[2], o0[3]); w.z = cvt_pk_bf16(o1[0], o1[1]); w.w = cvt_pk_bf16(o1[2], o1[3]);
                    *(u32x4*)(rowp + bj * 32) = w; }
            }
        }
    }
};

template <bool RECON> struct EpiResStats {
    static constexpr bool PERM = true, AFTER_DRAIN = false;
    const float* xp; const float* xs; bf16_t* xb; float* stats; const float* xinv; const float* g1;
    __device__ __forceinline__ void operator()(const f32x4 (&acc)[2][2][4][2], const Unit& u, int wr, int wc, int fr, int fq) const {
        const int rowt = u.pm * BM; const float* base = rowt < ROWS_PROMPT ? xp : xs - (size_t)ROWS_PROMPT * 1024;
        const int col0 = u.pn * BM + wc * 32 + 8 * fq;
        f32x4 gi[2][2];
        if constexpr (RECON) {
#pragma unroll
            for (int bj = 0; bj < 2; ++bj)
#pragma unroll
                for (int n = 0; n < 2; ++n) { const f32x4 g = *(const f32x4*)(g1 + col0 + bj * HALF + n * 4); gi[bj][n] = (f32x4){__builtin_amdgcn_rcpf(g[0]), __builtin_amdgcn_rcpf(g[1]), __builtin_amdgcn_rcpf(g[2]), __builtin_amdgcn_rcpf(g[3])}; }
        }
#pragma unroll
        for (int ai = 0; ai < 2; ++ai)
#pragma unroll
            for (int m = 0; m < 4; ++m) { const int r = rowt + ai * HALF + wr * 64 + m * 16 + fr; const size_t off = (size_t)r * 1024 + col0; float ss = 0.f;
                float xi = 0.f; if constexpr (RECON) xi = xinv[r];
#pragma unroll
                for (int bj = 0; bj < 2; ++bj) { f32x4 b0, b1;
                    if constexpr (RECON) { const u32x4 w = *(const u32x4*)(xb + off + bj * HALF);
                        b0 = (f32x4){__builtin_bit_cast(float, w.x << 16), __builtin_bit_cast(float, w.x & 0xffff0000u), __builtin_bit_cast(float, w.y << 16), __builtin_bit_cast(float, w.y & 0xffff0000u)} * xi * gi[bj][0];
                        b1 = (f32x4){__builtin_bit_cast(float, w.z << 16), __builtin_bit_cast(float, w.z & 0xffff0000u), __builtin_bit_cast(float, w.w << 16), __builtin_bit_cast(float, w.w & 0xffff0000u)} * xi * gi[bj][1]; }
                    else { b0 = *(const f32x4*)(base + off + bj * HALF); b1 = *(const f32x4*)(base + off + bj * HALF + 4); }
                    const f32x4 o0 = b0 + acc[ai][bj][m][0], o1 = b1 + acc[ai][bj][m][1];
                    ss += ((o0[0] * o0[0] + o0[1] * o0[1]) + (o0[2] * o0[2] + o0[3] * o0[3])) + ((o1[0] * o1[0] + o1[1] * o1[1]) + (o1[2] * o1[2] + o1[3] * o1[3]));
                    u32x4 w2; w2.x = cvt_pk_bf16(o0[0], o0[1]); w2.y = cvt_pk_bf16(o0[2], o0[3]); w2.z = cvt_pk_bf16(o1[0], o1[1]); w2.w = cvt_pk_bf16(o1[2], o1[3]); *(u32x4*)(xb + off + bj * HALF) = w2; }
                ss += __shfl_xor(ss, 16); ss += __shfl_xor(ss, 32);
                if (fq == 0) stats[(size_t)r * 16 + u.pn * 4 + wc] = ss;
                if (!RECON && m == 3) asm volatile("" ::: "memory"); }
    }
};

constexpr int UP_TAB_ROUNDS = 12;
struct EpiUp {
    static constexpr bool PERM = true, AFTER_DRAIN = false;
    bf16_t* H; const float* stats; const PG8_LAS float* tab;
    __device__ __forceinline__ void operator()(const f32x4 (&acc)[2][2][4][2], const Unit& u, int wr, int wc, int fr, int fq) const {
        const int row0 = u.pm * BM + wr * 64 + fr; const int col0 = u.pn * BM + wc * 32 + 8 * fq;
#pragma unroll
        for (int ai = 0; ai < 2; ++ai)
#pragma unroll
            for (int m = 0; m < 4; ++m) { const int r = row0 + ai * HALF + m * 16;
                float rstd;
                if (u.idx < UP_TAB_ROUNDS) rstd = tab[u.idx * BM + ai * HALF + wr * 64 + m * 16 + fr];
                else { const f32x4 p = *(const f32x4*)(stats + (size_t)r * 16 + 4 * fq); float s = (p[0] + p[1]) + (p[2] + p[3]);
                    s += __shfl_xor(s, 16); s += __shfl_xor(s, 32); rstd = __builtin_amdgcn_rsqf(s * (1.0f / 1024.0f) + RMS_EPS); }
                bf16_t* rowp = H + (size_t)r * 4096 + col0;
#pragma unroll
                for (int bj = 0; bj < 2; ++bj) { f32x4 v0 = acc[ai][bj][m][0] * rstd, v1 = acc[ai][bj][m][1] * rstd;
#pragma unroll
                    for (int e = 0; e < 4; ++e) { const float a = fmaxf(v0[e], 0.f), b = fmaxf(v1[e], 0.f); v0[e] = a * a; v1[e] = b * b; }
                    u32x4 w; w.x = cvt_pk_bf16(v0[0], v0[1]); w.y = cvt_pk_bf16(v0[2], v0[3]); w.z = cvt_pk_bf16(v1[0], v1[1]); w.w = cvt_pk_bf16(v1[2], v1[3]);
                    *(u32x4*)(rowp + bj * HALF) = w; } }
    }
};

struct EpiDown {
    static constexpr bool PERM = true, AFTER_DRAIN = false;
    float* out; const bf16_t* xb;
    __device__ __forceinline__ void operator()(const f32x4 (&acc)[2][2][4][2], const Unit& u, int wr, int wc, int fr, int fq) const {
        const int col0 = u.pn * BM + wc * 32 + 8 * fq;
#pragma unroll
        for (int ai = 0; ai < 2; ++ai)
#pragma unroll
            for (int m = 0; m < 4; ++m) { const int r = u.pm * BM + ai * HALF + wr * 64 + m * 16 + fr; const size_t off = (size_t)r * 1024 + col0;
#pragma unroll
                for (int bj = 0; bj < 2; ++bj) { const u32x4 w = *(const u32x4*)(xb + off + bj * HALF);
                    const f32x4 b0 = {__builtin_bit_cast(float, w.x << 16), __builtin_bit_cast(float, w.x & 0xffff0000u), __builtin_bit_cast(float, w.y << 16), __builtin_bit_cast(float, w.y & 0xffff0000u)};
                    const f32x4 b1 = {__builtin_bit_cast(float, w.z << 16), __builtin_bit_cast(float, w.z & 0xffff0000u), __builtin_bit_cast(float, w.w << 16), __builtin_bit_cast(float, w.w & 0xffff0000u)};
                    *(f32x4*)(out + off + bj * HALF) = b0 + acc[ai][bj][m][0]; *(f32x4*)(out + off + bj * HALF + 4) = b1 + acc[ai][bj][m][1]; } }
    }
};

template <class Epi, class Sched, bool ALIGN_EPI = false, bool SP2 = false>
__device__ __forceinline__ void gemm_phase(PG8_LAS unsigned char* lds, const Gemm g, const Sched& S, const Epi& E) {
    const int tid = threadIdx.x, wid = __builtin_amdgcn_readfirstlane(tid >> 6), lane = tid & 63, wr = wid >> 2, wc = wid & 3, fr = lane & 15, fq = lane >> 4;
    const int K = g.K, nt = K / BK;
    unsigned voffA[2], voffB[2];
#pragma unroll
    for (int i = 0; i < 2; ++i) { int R, C; stage_rc(tid * 16 + i * 8192, R, C); const int Rb = Epi::PERM ? ((R & ~31) + perm32(R & 31)) : R;
        voffA[i] = (unsigned)(R * K + C) * 2u; voffB[i] = (unsigned)(Rb * K + C) * 2u; }
    const size_t kstep = (size_t)(BK * 2);
    const size_t hstep = (size_t)HALF * K * 2;
    const size_t tstep = 2 * hstep;
    const unsigned ldsw = (unsigned)wid * 1024u;
    const int aoff = lds_byte(wr * 64 + fr, fq * 8), boff = lds_byte(wc * 32 + fr, fq * 8);
#define PG8_SA(b, h) (((b) * 2 + (h)) * HTB)
#define PG8_SB(b, h) ((4 + (b) * 2 + (h)) * HTB)
#define PG8_STAGE(bufoff, gbase, voff) do { _Pragma("unroll") for (int _i = 0; _i < 2; ++_i) \
        __builtin_amdgcn_global_load_lds((const unsigned*)((const char*)(gbase) + (voff)[_i]), (PG8_LAS unsigned*)(lds + (bufoff) + ldsw + _i * 8192), 16, 0, 0); } while (0)
#define PG8_LDA(dst, b, h) do { _Pragma("unroll") for (int m = 0; m < 4; ++m) _Pragma("unroll") for (int k = 0; k < 2; ++k) dst[m][k] = *(const PG8_LAS bf16x8*)(lds + PG8_SA(b, h) + aoff + m * 2048 + k * 1024); } while (0)
#define PG8_LDB(dst, b, h) do { _Pragma("unroll") for (int n = 0; n < 2; ++n) _Pragma("unroll") for (int k = 0; k < 2; ++k) dst[n][k] = *(const PG8_LAS bf16x8*)(lds + PG8_SB(b, h) + boff + n * 2048 + k * 1024); } while (0)
#define PG8_MMA(ai, bj, At, Bt) do { __builtin_amdgcn_s_setprio(1); _Pragma("unroll") for (int m = 0; m < 4; ++m) _Pragma("unroll") for (int n = 0; n < 2; ++n) _Pragma("unroll") for (int k = 0; k < 2; ++k) \
        acc[ai][bj][m][n] = __builtin_amdgcn_mfma_f32_16x16x32_bf16(Bt[n][k], At[m][k], acc[ai][bj][m][n], 0, 0, 0); __builtin_amdgcn_s_setprio(0); } while (0)
#define PG8_WAIT_V(n) asm volatile("s_waitcnt vmcnt(" #n ")" ::: "memory")
#define PG8_WAIT_L(n) asm volatile("s_waitcnt lgkmcnt(" #n ")" ::: "memory")
#define PG8_BAR __builtin_amdgcn_s_barrier()
#define PG8_SCHED __builtin_amdgcn_sched_barrier(0)
    Unit cur, nxt; int ui = 0;
    if (!S.next(0, cur)) return;
    f32x4 acc[2][2][4][2];
#pragma unroll
    for (int a = 0; a < 2; ++a)
#pragma unroll
        for (int b = 0; b < 2; ++b)
#pragma unroll
            for (int m = 0; m < 4; ++m)
#pragma unroll
                for (int n = 0; n < 2; ++n) acc[a][b][m][n] = (f32x4){0.f, 0.f, 0.f, 0.f};
    bf16x8 At[4][2], B0[2][2], B1[2][2];
    const char* cA = (const char*)g.A + (size_t)cur.pm * tstep; const char* cB = (const char*)g.Bt + (size_t)cur.pn * tstep;
    S.a_ready(cur);
    if constexpr (SP2) {
        PG8_STAGE(PG8_SB(0, 0), cB, voffB); PG8_STAGE(PG8_SB(0, 1), cB + hstep, voffB); PG8_STAGE(PG8_SA(0, 0), cA, voffA); PG8_STAGE(PG8_SA(0, 1), cA + hstep, voffA);
        if (wr == 1) PG8_BAR;
        PG8_WAIT_V(2); PG8_BAR;
        PG8_STAGE(PG8_SB(1, 0), cB + kstep, voffB); PG8_STAGE(PG8_SA(1, 0), cA + kstep, voffA); PG8_STAGE(PG8_SB(1, 1), cB + hstep + kstep, voffB);
        PG8_WAIT_V(6); PG8_BAR;
    } else {
        PG8_STAGE(PG8_SB(0, 0), cB, voffB); PG8_STAGE(PG8_SA(0, 0), cA, voffA); PG8_STAGE(PG8_SB(0, 1), cB + hstep, voffB); PG8_STAGE(PG8_SA(0, 1), cA + hstep, voffA);
        if (wr == 1) PG8_BAR;
        PG8_WAIT_V(4); PG8_BAR;
        PG8_STAGE(PG8_SB(1, 0), cB + kstep, voffB); PG8_STAGE(PG8_SA(1, 0), cA + kstep, voffA); PG8_STAGE(PG8_SB(1, 1), cB + hstep + kstep, voffB);
        PG8_WAIT_V(6); PG8_BAR;
    }
    for (;;) {
        const bool has_next = S.next(ui + 1, nxt);
        const char* nA = has_next ? (const char*)g.A + (size_t)nxt.pm * tstep : cA; const char* nB = has_next ? (const char*)g.Bt + (size_t)nxt.pn * tstep : cB;
        for (int t = 0; t < nt; t += 2) {
            const bool last = (t == nt - 2);
            const char* a1 = cA + (size_t)(t + 1) * kstep;
            const char* a2 = last ? nA : cA + (size_t)(t + 2) * kstep; const char* b2 = last ? nB : cB + (size_t)(t + 2) * kstep;
            const char* a3 = a2 + kstep; const char* b3 = b2 + kstep;
            if (last && has_next) S.a_ready(nxt);
            if constexpr (SP2) {
            PG8_LDB(B0, 0, 0); PG8_LDB(B1, 0, 1); PG8_SCHED; PG8_LDA(At, 0, 0); PG8_STAGE(PG8_SA(1, 1), a1 + hstep, voffA);
            PG8_WAIT_V(8); PG8_WAIT_L(0); PG8_BAR; PG8_MMA(0, 0, At, B0); PG8_MMA(0, 1, At, B1); PG8_BAR; PG8_SCHED;
            PG8_LDA(At, 0, 1); PG8_STAGE(PG8_SB(0, 0), b2, voffB); PG8_STAGE(PG8_SB(0, 1), b2 + hstep, voffB); PG8_STAGE(PG8_SA(0, 0), a2, voffA);
            PG8_WAIT_V(8); PG8_WAIT_L(0); PG8_BAR; PG8_MMA(1, 0, At, B0); PG8_MMA(1, 1, At, B1); PG8_BAR; PG8_SCHED;
            PG8_LDB(B0, 1, 0); PG8_LDB(B1, 1, 1); PG8_SCHED; PG8_LDA(At, 1, 0); PG8_STAGE(PG8_SA(0, 1), a2 + hstep, voffA);
            PG8_WAIT_V(8); PG8_WAIT_L(0); PG8_BAR; PG8_MMA(0, 0, At, B0); PG8_MMA(0, 1, At, B1); PG8_BAR; PG8_SCHED;
            PG8_LDA(At, 1, 1); PG8_STAGE(PG8_SB(1, 0), b3, voffB); PG8_STAGE(PG8_SB(1, 1), b3 + hstep, voffB); PG8_STAGE(PG8_SA(1, 0), a3, voffA);
            PG8_WAIT_V(8); PG8_WAIT_L(0); PG8_BAR; PG8_MMA(1, 0, At, B0); PG8_MMA(1, 1, At, B1); PG8_BAR; PG8_SCHED;
            } else {
            PG8_LDB(B0, 0, 0); PG8_SCHED; PG8_LDA(At, 0, 0); PG8_STAGE(PG8_SA(1, 1), a1 + hstep, voffA);
            PG8_WAIT_L(8); PG8_BAR; PG8_WAIT_L(0); PG8_MMA(0, 0, At, B0); PG8_BAR; PG8_SCHED;
            PG8_LDB(B1, 0, 1); PG8_STAGE(PG8_SB(0, 0), b2, voffB);
            PG8_BAR; PG8_WAIT_L(0); PG8_MMA(0, 1, At, B1); PG8_BAR;
            PG8_LDA(At, 0, 1); PG8_STAGE(PG8_SA(0, 0), a2, voffA);
            PG8_BAR; PG8_WAIT_L(0); PG8_MMA(1, 0, At, B0); PG8_BAR; PG8_SCHED;
            PG8_STAGE(PG8_SB(0, 1), b2 + hstep, voffB);
            PG8_WAIT_V(6); PG8_BAR; PG8_MMA(1, 1, At, B1); PG8_BAR;
            PG8_LDB(B0, 1, 0); PG8_SCHED; PG8_LDA(At, 1, 0); PG8_STAGE(PG8_SA(0, 1), a2 + hstep, voffA);
            PG8_WAIT_L(8); PG8_BAR; PG8_WAIT_L(0); PG8_MMA(0, 0, At, B0); PG8_BAR; PG8_SCHED;
            PG8_LDB(B1, 1, 1); PG8_STAGE(PG8_SB(1, 0), b3, voffB);
            PG8_BAR; PG8_WAIT_L(0); PG8_MMA(0, 1, At, B1); PG8_BAR;
            PG8_LDA(At, 1, 1); PG8_STAGE(PG8_SA(1, 0), a3, voffA);
            PG8_BAR; PG8_WAIT_L(0); PG8_MMA(1, 0, At, B0); PG8_BAR; PG8_SCHED;
            PG8_STAGE(PG8_SB(1, 1), b3 + hstep, voffB);
            PG8_WAIT_V(6); PG8_BAR; PG8_MMA(1, 1, At, B1); PG8_BAR;
            }
        }
        if constexpr (ALIGN_EPI) { if (wr == 0) PG8_BAR; }
        if constexpr (!Epi::AFTER_DRAIN) { E(acc, cur, wr, wc, fr, fq); S.done(cur); }
        if (!has_next) break;
#pragma unroll
        for (int a = 0; a < 2; ++a)
#pragma unroll
            for (int b = 0; b < 2; ++b)
#pragma unroll
                for (int m = 0; m < 4; ++m)
#pragma unroll
                    for (int n = 0; n < 2; ++n) acc[a][b][m][n] = (f32x4){0.f, 0.f, 0.f, 0.f};
        cur = nxt; cA = nA; cB = nB; ++ui;
        if constexpr (ALIGN_EPI) { if (wr == 1) PG8_BAR; }
    }
    PG8_WAIT_V(0);
    if constexpr (!ALIGN_EPI) { if (wr == 0) PG8_BAR; }
    PG8_BAR;
    if constexpr (Epi::AFTER_DRAIN) { E.fused(acc, cur, wr, wc, fr, fq, lds, wid, lane); S.done(cur); }
#undef PG8_SA
#undef PG8_SB
#undef PG8_STAGE
#undef PG8_LDA
#undef PG8_LDB
#undef PG8_MMA
#undef PG8_WAIT_V
#undef PG8_WAIT_L
#undef PG8_BAR
#undef PG8_SCHED
}
}

#ifndef PG8_SP2
#define PG8_SP2 true
#endif
#ifndef PG8_ALIGN
#define PG8_ALIGN true
#endif
#include <hip/hip_bf16.h>
#include <cmath>
namespace attn_body {
using bf16=__hip_bfloat16;
using bf16x8=__attribute__((ext_vector_type(8)))short;
using s16x4=__attribute__((ext_vector_type(4)))short;
using f32x16=__attribute__((ext_vector_type(16)))float;
using u32x4=__attribute__((ext_vector_type(4)))unsigned;
constexpr int D=64,QP=1024,KP=256;
constexpr int NW=8,QBLK=32,QB=QBLK*NW,KVBLK=64;
constexpr int ATTN_UNIT_ROWS=QB;
__device__ __forceinline__ int crow(int r,int hi){return (r&3)+8*(r>>2)+4*hi;}
#define SBAR() __builtin_amdgcn_sched_barrier(0)
constexpr int NSLOT=3, SLOTB=8192;
constexpr int LDS_K=0, LDS_V=NSLOT*SLOTB, LDS_WS=2*NSLOT*SLOTB, LDS_OST=LDS_WS+NW*64*4, LDS_BYTES=LDS_OST+NW*4096;
constexpr float C2=0.125f*1.4426950408889634f;
__device__ __forceinline__ void glds16(const void*gsrc,unsigned lds_dst){unsigned keep;
  asm volatile("s_mov_b32 %0, m0\n\ts_mov_b32 m0, %2\n\ts_nop 0\n\tglobal_load_lds_dwordx4 %1, off\n\ts_mov_b32 m0, %0":"=&s"(keep):"v"(gsrc),"s"(lds_dst):"memory");}
__device__ __forceinline__ float max3f(float a,float b,float c){float r;asm("v_max3_f32 %0, %1, %2, %3":"=v"(r):"v"(a),"v"(b),"v"(c));return r;}
__device__ __forceinline__ float max2f(float a,float b){float r;asm("v_max_f32_e32 %0, %1, %2":"=v"(r):"v"(a),"v"(b));return r;}
__device__ __forceinline__ float fadd_s(float a,float b){float r;asm("v_add_f32_e32 %0, %1, %2":"=v"(r):"v"(a),"v"(b));return r;}
__device__ __forceinline__ float fsub_s(float a,float b){float r;asm("v_sub_f32_e32 %0, %1, %2":"=v"(r):"v"(a),"v"(b));return r;}
typedef float f32x2_t __attribute__((ext_vector_type(2))); typedef __bf16 bf16x2_t __attribute__((ext_vector_type(2)));
__device__ __forceinline__ unsigned cvtpk_s(float lo,float hi){f32x2_t v={lo,hi};bf16x2_t b=__builtin_convertvector(v,bf16x2_t);return __builtin_bit_cast(unsigned,b);}
#define WAIT_BAR(N) asm volatile("s_waitcnt vmcnt(" #N ") lgkmcnt(0)\n\ts_barrier":::"memory")

__device__ __forceinline__ void qkt(f32x16&p0,f32x16&p1,const char*Kslot,const bf16x8*qr,const f32x16&negm,int r32,int hi){
  const char*kb=Kslot+hi*1024+r32*16;
  #pragma unroll
  for(int d0=0;d0<4;++d0){
    const bf16x8 b0=*reinterpret_cast<const bf16x8*>(kb+d0*2048);
    const bf16x8 b1=*reinterpret_cast<const bf16x8*>(kb+d0*2048+512);
    if(d0==0){p0=__builtin_amdgcn_mfma_f32_32x32x16_bf16(b0,qr[0],negm,0,0,0);p1=__builtin_amdgcn_mfma_f32_32x32x16_bf16(b1,qr[0],negm,0,0,0);}
    else{p0=__builtin_amdgcn_mfma_f32_32x32x16_bf16(b0,qr[d0],p0,0,0,0);p1=__builtin_amdgcn_mfma_f32_32x32x16_bf16(b1,qr[d0],p1,0,0,0);}}
}
typedef __attribute__((address_space(3))) const char* lds_cptr;
typedef short v4i16_t __attribute__((ext_vector_type(4)));
__device__ __forceinline__ void kload8(bf16x8*kf,lds_cptr kp){
  kf[0]=*(const __attribute__((address_space(3))) bf16x8*)(kp);      kf[1]=*(const __attribute__((address_space(3))) bf16x8*)(kp+512);
  kf[2]=*(const __attribute__((address_space(3))) bf16x8*)(kp+2048); kf[3]=*(const __attribute__((address_space(3))) bf16x8*)(kp+2560);
  kf[4]=*(const __attribute__((address_space(3))) bf16x8*)(kp+4096); kf[5]=*(const __attribute__((address_space(3))) bf16x8*)(kp+4608);
  kf[6]=*(const __attribute__((address_space(3))) bf16x8*)(kp+6144); kf[7]=*(const __attribute__((address_space(3))) bf16x8*)(kp+6656);
}
__device__ __forceinline__ void kload2(bf16x8*kf,lds_cptr kp,int j){ kf[2*j]=*(const __attribute__((address_space(3))) bf16x8*)(kp+j*2048); kf[2*j+1]=*(const __attribute__((address_space(3))) bf16x8*)(kp+j*2048+512); }
__device__ __forceinline__ s16x4 vtr(lds_cptr p){ return __builtin_bit_cast(s16x4,__builtin_amdgcn_ds_read_tr16_b64_v4i16((__attribute__((address_space(3))) v4i16_t*)p)); }
__device__ __forceinline__ float rowmax(const f32x16&p0,const f32x16&p1){
  float a=max3f(p0[0],p0[1],p1[0]),b=max3f(p0[2],p0[3],p1[1]);a=max3f(a,p1[2],p1[3]);
  #pragma unroll
  for(int r=4;r<16;r+=4){a=max3f(a,p0[r],p0[r+1]);b=max3f(b,p0[r+2],p0[r+3]);a=max3f(a,p1[r],p1[r+1]);b=max3f(b,p1[r+2],p1[r+3]);}
  const float m=max2f(a,b);
  auto rr=__builtin_amdgcn_permlane32_swap(__float_as_uint(m),__float_as_uint(m),false,false);
  return max2f(__uint_as_float(rr[0]),__uint_as_float(rr[1]));
}
__device__ __forceinline__ void pv(f32x16*o,int vb,bf16x8 pa0,bf16x8 pa1,bf16x8 pa2,bf16x8 pa3){
  #pragma unroll
  for(int d0=0;d0<2;++d0){s16x4 lo[4],hi[4];
    #pragma unroll
    for(int ks=0;ks<4;++ks){
      asm volatile("ds_read_b64_tr_b16 %0,%1 offset:%c2":"=&v"(lo[ks]):"v"(vb),"i"(d0*4096+ks*1024):"memory");
      asm volatile("ds_read_b64_tr_b16 %0,%1 offset:%c2":"=&v"(hi[ks]):"v"(vb),"i"(d0*4096+ks*1024+512):"memory");}
    asm volatile("s_waitcnt lgkmcnt(0)":::"memory");SBAR();
    #define PK(k) (bf16x8){lo[k][0],lo[k][1],lo[k][2],lo[k][3],hi[k][0],hi[k][1],hi[k][2],hi[k][3]}
    o[d0]=__builtin_amdgcn_mfma_f32_32x32x16_bf16(pa0,PK(0),o[d0],0,0,0);
    o[d0]=__builtin_amdgcn_mfma_f32_32x32x16_bf16(pa1,PK(1),o[d0],0,0,0);
    o[d0]=__builtin_amdgcn_mfma_f32_32x32x16_bf16(pa2,PK(2),o[d0],0,0,0);
    o[d0]=__builtin_amdgcn_mfma_f32_32x32x16_bf16(pa3,PK(3),o[d0],0,0,0);
    #undef PK
  }
}

#ifndef ATTN_STORE16
#define ATTN_STORE16(p,v) (*(u32x4*)(p)=(v))
#endif
template<int THRL,bool NOMAX> __device__ __forceinline__ void attn_unit(long rowbase,int NT,int h,int qb,const bf16*Q,const bf16*__restrict__ Kh,const bf16*__restrict__ Vh,bf16*O,char*shm,
    bool first,bool has_next,long n_rowbase,int n_h,int n_qb,const bf16*__restrict__ n_Kh,bf16x8 (&qr)[4]){
  const int tid=threadIdx.x,lane=tid&63,r32=lane&31,hi=lane>>5; const int wid=__builtin_amdgcn_readfirstlane(tid>>6);
  const int q0=qb*QB;
  const bf16*Qw=Q+(rowbase+q0+wid*QBLK)*QP+h*D;
  const unsigned lds0=(unsigned)(uintptr_t)shm;
  float*wsf=(float*)(shm+LDS_WS)+wid*64;
  const bf16*ksrc=Kh+(long)lane*KP+wid*8;
  const bf16*vsrc=Vh+(long)(16*(wid&3)+(lane>>2))*KP+(wid>>2)*32+(lane&3)*8;
  const unsigned kdst=lds0+LDS_K+wid*1024, vdst=lds0+LDS_V+wid*1024;
  #define DMA_K(t,slot) glds16(ksrc+(long)(t)*KVBLK*KP,(unsigned)__builtin_amdgcn_readfirstlane(kdst+(slot)))
  #define DMA_V(t,slot) glds16(vsrc+(long)(t)*KVBLK*KP,(unsigned)__builtin_amdgcn_readfirstlane(vdst+(slot)))
  const int vb0=(int)(lds0+LDS_V)+((lane>>4)&1)*32+(lane&3)*8+(4*hi+((lane&15)>>2))*64;
  const char*Kbase=shm+LDS_K; bf16x8 kf[8];
  const lds_cptr shm3=(lds_cptr)shm; const lds_cptr kp0=shm3+LDS_K+hi*1024+r32*16; const lds_cptr vp0=shm3+LDS_V+((lane>>4)&1)*32+(lane&3)*8+(4*hi+((lane&15)>>2))*64;
  if(first){ DMA_K(0,0);DMA_V(0,0);DMA_K(1,SLOTB);
  #pragma unroll
  for(int d0=0;d0<4;++d0)qr[d0]=*reinterpret_cast<const bf16x8*>(&Qw[(long)r32*QP+d0*16+hi*8]); }
  float mhat=0.f,l_reg=0.f;f32x16 o[2];o[0]=f32x16{};o[1]=f32x16{};f32x16 negm=f32x16{};asm volatile("":"+v"(negm));
  #define CMASK(P0,P1,t) do{}while(0)
  bool resc=false;
  #define START(P0,P1) do{ const float rm=rowmax(P0,P1); resc=false; \
    { const float dl=rm; mhat=fadd_s(mhat,dl); \
      _Pragma("unroll") for(int r=0;r<16;++r){P0[r]=fsub_s(P0[r],dl);P1[r]=fsub_s(P1[r],dl);} \
      _Pragma("unroll") for(int r=0;r<16;++r)negm[r]=-mhat; asm volatile("":"+v"(negm)); } \
    _Pragma("unroll") for(int r=0;r<16;++r)P0[r]=__builtin_amdgcn_exp2f(P0[r]); }while(0)
  #define RESC() do{ if(resc){ asm volatile("s_waitcnt lgkmcnt(0)":::"memory"); \
      _Pragma("unroll") for(int d_=0;d_<2;++d_) _Pragma("unroll") for(int r=0;r<16;++r)o[d_][r]*=wsf[crow(r,hi)]; } }while(0)
  f32x16 pA0,pA1,pB0,pB1;
  int sl_prev=0,sl_cur=0,sl_next=SLOTB;
  #define ROT() do{sl_prev=sl_cur;sl_cur=sl_next;sl_next=(sl_next==(NSLOT-1)*SLOTB)?0:sl_next+SLOTB;}while(0)
  if(first){ DMA_K(2,2*SLOTB);
  WAIT_BAR(3); }
  else { DMA_V(0,0); WAIT_BAR(1); }
  qkt(pA0,pA1,Kbase,qr,negm,r32,hi);asm volatile("s_nop 15\n\ts_nop 7":"+v"(pA0),"+v"(pA1));CMASK(pA0,pA1,0);
  START(pA0,pA1);
  _Pragma("unroll") for(int r=0;r<16;++r)pA1[r]=__builtin_amdgcn_exp2f(pA1[r]);
  WAIT_BAR(0);
  DMA_K(3,0);DMA_V(1,SLOTB);
  ROT();
  kload8(kf,kp0+sl_cur);
  WAIT_BAR(2);
  s16x4 vlo[8],vhi[8]; u32x4 pw0,pw1,pw2,pw3;
  #define PKW(P,B) cvtpk_s(P[B],P[B+1])
  #define PAF(k) __builtin_bit_cast(bf16x8,pw##k)
  #define VFR(i) (bf16x8){vlo[i][0],vlo[i][1],vlo[i][2],vlo[i][3],vhi[i][0],vhi[i][1],vhi[i][2],vhi[i][3]}
  #define PIN(x) asm volatile("":"+v"(x))
  #define MX3(a,b,c) __builtin_fmaxf(__builtin_fmaxf((a),(b)),(c))
  #define GAPA(MF,A0,A1,A2,A3,W0,W1,PW) do{ MF; sacc+=A0; sacc+=A1; sacc+=A2; sacc+=A3; PIN(sacc); W0; W1; PIN(PW); SBAR(); }while(0)
  #define EX(v) __builtin_amdgcn_exp2f(v)
  #define GAPB(MF,X,B) do{ MF; X[B]=EX(X[B]); X[B+1]=EX(X[B+1]); X[B+2]=EX(X[B+2]); X[B+3]=EX(X[B+3]); PIN(X); SBAR(); }while(0)
  #define VRD(i) do{ vlo[i]=vtr(vp_+(((i)>>2)*4096+((i)&3)*1024)); vhi[i]=vtr(vp_+(((i)>>2)*4096+((i)&3)*1024+512)); }while(0)
  #define KRD(G,j) do{ if(G){ kload2(kf,kp0+sl_next,j); SBAR(); } }while(0)
  #define STEP(C0,C1,P0,P1,t,GK,GV,GL) do{ SBAR(); \
    const lds_cptr vp_=vp0+sl_prev; \
    VRD(0); SBAR(); float sacc=(P0[0]+P0[1]); \
    GAPA(C0=__builtin_amdgcn_mfma_f32_32x32x16_bf16(kf[0],qr[0],negm,0,0,0), P0[2],P0[3],P0[4],P0[5],     pw0[0]=PKW(P0,0), pw0[1]=PKW(P0,2), pw0); \
    VRD(4); SBAR(); GAPA(C1=__builtin_amdgcn_mfma_f32_32x32x16_bf16(kf[1],qr[0],negm,0,0,0), P0[6],P0[7],P0[8],P0[9],     pw0[2]=PKW(P0,4), pw0[3]=PKW(P0,6), pw0); \
    VRD(1); SBAR(); GAPA(C0=__builtin_amdgcn_mfma_f32_32x32x16_bf16(kf[2],qr[1],C0,0,0,0),   P0[10],P0[11],P0[12],P0[13], pw1[0]=PKW(P0,8), pw1[1]=PKW(P0,10), pw1); \
    VRD(5); SBAR(); GAPA(C1=__builtin_amdgcn_mfma_f32_32x32x16_bf16(kf[3],qr[1],C1,0,0,0),   P0[14],P0[15],P1[0],P1[1],   pw1[2]=PKW(P0,12),pw1[3]=PKW(P0,14), pw1); \
    VRD(2); SBAR(); GAPA(C0=__builtin_amdgcn_mfma_f32_32x32x16_bf16(kf[4],qr[2],C0,0,0,0),   P1[2],P1[3],P1[4],P1[5],     pw2[0]=PKW(P1,0), pw2[1]=PKW(P1,2), pw2); \
    VRD(6); SBAR(); GAPA(C1=__builtin_amdgcn_mfma_f32_32x32x16_bf16(kf[5],qr[2],C1,0,0,0),   P1[6],P1[7],P1[8],P1[9],     pw2[2]=PKW(P1,4), pw2[3]=PKW(P1,6), pw2); \
    VRD(3); SBAR(); GAPA(C0=__builtin_amdgcn_mfma_f32_32x32x16_bf16(kf[6],qr[3],C0,0,0,0),   P1[10],P1[11],P1[12],P1[13], pw3[0]=PKW(P1,8), pw3[1]=PKW(P1,10), pw3); \
    VRD(7); SBAR(); GAPA(C1=__builtin_amdgcn_mfma_f32_32x32x16_bf16(kf[7],qr[3],C1,0,0,0),   P1[14],P1[15],0.f,0.f,       pw3[2]=PKW(P1,12),pw3[3]=PKW(P1,14), pw3); \
    l_reg+=sacc; \
    if(GK){DMA_K((t)+3,sl_cur);} if(GV){DMA_V((t)+1,sl_next);} \
    CMASK(C0,C1,t); \
    if constexpr(NOMAX){ resc=false; } else { float a=MX3(C0[0],C0[1],C1[0]),b=MX3(C0[2],C0[3],C1[1]); a=MX3(a,C1[2],C1[3]); \
      _Pragma("unroll") for(int r=4;r<16;r+=4){a=MX3(a,C0[r],C0[r+1]);b=MX3(b,C0[r+2],C0[r+3]);a=MX3(a,C1[r],C1[r+1]);b=MX3(b,C1[r+2],C1[r+3]);} \
      float rm=__builtin_fmaxf(a,b); { auto rr=__builtin_amdgcn_permlane32_swap(__float_as_uint(rm),__float_as_uint(rm),false,false); rm=__builtin_fmaxf(__uint_as_float(rr[0]),__uint_as_float(rr[1])); } \
      resc=false; \
      if(__builtin_expect(__any(rm>(float)THRL),0)){ const float dl=__builtin_fmaxf(rm,0.f); mhat+=dl; \
        _Pragma("unroll") for(int r=0;r<16;++r){C0[r]-=dl;C1[r]-=dl;} \
        _Pragma("unroll") for(int r=0;r<16;++r)negm[r]=-mhat; asm volatile("":"+v"(negm)); \
        const float f=__builtin_amdgcn_exp2f(-dl); l_reg*=f; if(hi==0)wsf[r32]=f; resc=true; } } \
    SBAR(); \
    GAPB(o[0]=__builtin_amdgcn_mfma_f32_32x32x16_bf16(PAF(0),VFR(0),o[0],0,0,0), C0,0); \
    GAPB(o[1]=__builtin_amdgcn_mfma_f32_32x32x16_bf16(PAF(0),VFR(4),o[1],0,0,0), C0,4); \
    KRD(GL,0); GAPB(o[0]=__builtin_amdgcn_mfma_f32_32x32x16_bf16(PAF(1),VFR(1),o[0],0,0,0), C0,8); \
    KRD(GL,1); GAPB(o[1]=__builtin_amdgcn_mfma_f32_32x32x16_bf16(PAF(1),VFR(5),o[1],0,0,0), C0,12); \
    KRD(GL,2); GAPB(o[0]=__builtin_amdgcn_mfma_f32_32x32x16_bf16(PAF(2),VFR(2),o[0],0,0,0), C1,0); \
    KRD(GL,3); GAPB(o[1]=__builtin_amdgcn_mfma_f32_32x32x16_bf16(PAF(2),VFR(6),o[1],0,0,0), C1,4); \
    GAPB(o[0]=__builtin_amdgcn_mfma_f32_32x32x16_bf16(PAF(3),VFR(3),o[0],0,0,0), C1,8); \
    GAPB(o[1]=__builtin_amdgcn_mfma_f32_32x32x16_bf16(PAF(3),VFR(7),o[1],0,0,0), C1,12); \
    }while(0)
  int t=1;
  #undef CMASK
  #define CMASK(P0,P1,t) do{}while(0)
  for(;t+5<NT;t+=2){
    STEP(pB0,pB1,pA0,pA1,t,true,true,true);     WAIT_BAR(2); RESC(); ROT();
    STEP(pA0,pA1,pB0,pB1,t+1,true,true,true);   WAIT_BAR(2); RESC(); ROT();
  }
  #undef CMASK
  #define CMASK(P0,P1,t) do{}while(0)
  #define ENDW(tt) do{ if((tt)+3<NT){WAIT_BAR(2);} else if((tt)+2<NT){WAIT_BAR(1);} else {WAIT_BAR(0);} }while(0)
  for(;t+1<NT;t+=2){
    STEP(pB0,pB1,pA0,pA1,t,(t+3<NT),(t+1<NT),(t+1<NT));       ENDW(t);   RESC(); ROT();
    STEP(pA0,pA1,pB0,pB1,t+1,(t+4<NT),(t+2<NT),(t+2<NT));     ENDW(t+1); RESC(); ROT();
  }
  if(has_next){ const bf16*ksn=n_Kh+(long)lane*KP+wid*8;
    glds16(ksn,(unsigned)__builtin_amdgcn_readfirstlane(kdst)); glds16(ksn+(long)KVBLK*KP,(unsigned)__builtin_amdgcn_readfirstlane(kdst+SLOTB)); glds16(ksn+(long)2*KVBLK*KP,(unsigned)__builtin_amdgcn_readfirstlane(kdst+2*SLOTB)); }
  STEP(pB0,pB1,pA0,pA1,NT-1,false,false,false);
  if(has_next){ const bf16*Qn=Q+(n_rowbase+n_qb*QB+wid*QBLK)*QP+n_h*D;
    _Pragma("unroll") for(int d0=0;d0<4;++d0)qr[d0]=*reinterpret_cast<const bf16x8*>(&Qn[(long)r32*QP+d0*16+hi*8]); }
  RESC();
  { float sacc=pB0[0]+pB0[1]; _Pragma("unroll") for(int r=2;r<16;++r)sacc+=pB0[r]; _Pragma("unroll") for(int r=0;r<16;++r)sacc+=pB1[r]; l_reg+=sacc;
    pw0=(u32x4){PKW(pB0,0),PKW(pB0,2),PKW(pB0,4),PKW(pB0,6)};pw1=(u32x4){PKW(pB0,8),PKW(pB0,10),PKW(pB0,12),PKW(pB0,14)};pw2=(u32x4){PKW(pB1,0),PKW(pB1,2),PKW(pB1,4),PKW(pB1,6)};pw3=(u32x4){PKW(pB1,8),PKW(pB1,10),PKW(pB1,12),PKW(pB1,14)};
    SBAR(); pv(o,vb0+sl_cur,PAF(0),PAF(1),PAF(2),PAF(3)); }
  #undef PKW
  #undef PAF
  #undef VFR
  #undef PIN
  #undef MX3
  #undef GAPA
  #undef GAPB
  #undef EX
  #undef VRD
  #undef KRD
  #undef STEP
  #undef ENDW
  {auto rr=__builtin_amdgcn_permlane32_swap(__float_as_uint(l_reg),__float_as_uint(l_reg),false,false);l_reg=__uint_as_float(rr[0])+__uint_as_float(rr[1]);}
  if(hi==0)wsf[32+r32]=l_reg;asm volatile("s_waitcnt lgkmcnt(0)":::"memory");
  float rli[16];
  #pragma unroll
  for(int r=0;r<16;++r)rli[r]=__builtin_amdgcn_rcpf(wsf[32+crow(r,hi)]);
  bf16*Ow=O+(rowbase+q0+wid*QBLK)*QP+h*D;
  { bf16*stg=(bf16*)(shm+LDS_OST)+wid*2048;
    #pragma unroll
    for(int r=0;r<16;++r){const int orow=crow(r,hi);
      #pragma unroll
      for(int d0=0;d0<2;++d0)stg[orow*64+d0*32+r32]=__float2bfloat16(o[d0][r]*rli[r]);}
    asm volatile("s_waitcnt lgkmcnt(0)":::"memory");
    #pragma unroll
    for(int i=0;i<4;++i){const int row=i*8+(lane>>3),ch=lane&7; const u32x4 v=*(const u32x4*)(stg+row*64+ch*8); ATTN_STORE16(Ow+(long)row*QP+ch*8,v);} }
  asm volatile("s_waitcnt lgkmcnt(0)\n\ts_barrier":::"memory");
  #undef DMA_K
  #undef DMA_V
  #undef CMASK
  #undef START
  #undef RESC
  #undef ROT
}
constexpr int ATTN_LDS_BYTES=LDS_BYTES;
#undef SBAR
#undef WAIT_BAR
}
constexpr int NWAVES = 8;
#ifndef MK_N_LAUNCHES
#define MK_N_LAUNCHES 1
#endif
#ifndef PROBE_PH
#define PROBE_PH -1
#endif
constexpr int N_LAUNCHES = MK_N_LAUNCHES;
constexpr int PER_PHASE = 6;

constexpr int D = 1024, FF = 4096, NIN = 1280, HD = 64;
constexpr int M = 49152;
constexpr int ROWS_P = 32768;
constexpr float EPS = 1e-6f;

constexpr size_t MiB = 1u << 20;
constexpr size_t WS_CTL = 0, CTL_ZERO_BYTES = 16384;
constexpr size_t WS_ROPE = 1 * MiB;
constexpr size_t WS_XINV = WS_ROPE + 65536;
constexpr size_t WS_STATS = 2 * MiB;
constexpr size_t WS_WIN = 6 * MiB, WS_WO = 9 * MiB, WS_WUP = 11 * MiB, WS_WDN = 19 * MiB;
constexpr size_t WS_XN = 32 * MiB;
constexpr size_t WS_MIX = 128 * MiB;
constexpr size_t WS_KV = 224 * MiB;
constexpr size_t WS_U = 248 * MiB;
constexpr size_t WS_H = 128 * MiB;
constexpr size_t WS_END = 512 * MiB;
static_assert(WS_WDN + (size_t)D * FF * 2 <= WS_XN && WS_XN + (size_t)M * D * 2 <= WS_MIX && WS_U + (size_t)M * 512 * 2 <= WS_END && WS_H + (size_t)M * FF * 2 <= WS_END && WS_STATS + (size_t)M * 64 <= WS_WIN, "d_ws map");

constexpr int RING_OFF = 0, RING_BYTES = 131072;
constexpr int LDSCTL_OFF = RING_BYTES, MISC_OFF = LDSCTL_OFF + 320;
constexpr int UPTAB_OFF = RING_BYTES + 2048;
constexpr int LDS_BYTES = 147456;
static_assert(UPTAB_OFF + 12 * 256 * 4 <= LDS_BYTES, "LDS map");

#define GAS __attribute__((address_space(1)))
#define LAS __attribute__((address_space(3)))
typedef unsigned short bf16;
typedef unsigned v4u __attribute__((ext_vector_type(4)));
typedef float f32x4 __attribute__((ext_vector_type(4)));
#define LDS_WAIT() asm volatile("s_waitcnt lgkmcnt(0)" ::: "memory")
__device__ __forceinline__ unsigned f2bf(float f) { unsigned u = __builtin_bit_cast(unsigned, f); return (u + 0x7fffu + ((u >> 16) & 1u)) >> 16; }
typedef float f32x2_pk __attribute__((ext_vector_type(2))); typedef __bf16 bf16x2_pk __attribute__((ext_vector_type(2)));
__device__ __forceinline__ unsigned pk2(float lo, float hi) { const f32x2_pk v = {lo, hi}; return __builtin_bit_cast(unsigned, __builtin_convertvector(v, bf16x2_pk)); }
__device__ __forceinline__ float bflo(unsigned w) { return __builtin_bit_cast(float, w << 16); }
__device__ __forceinline__ float bfhi(unsigned w) { return __builtin_bit_cast(float, w & 0xffff0000u); }

#define XB_TMO      128
#define XB_XCNT(j)  (256  + 64 * (j))
#define XB_XSUB(j)  (1280 + 64 * (j))
#define XB_XGEN(j)  (2304 + 64 * (j))
#define XB_TOP      3328
#define XB_TOPGEN   3392
#define XCD_BAR_WORDS 3456
#define XB_SPIN_CAP (1u << 18)

__device__ __forceinline__ unsigned xb_ld(unsigned* p)              { return __hip_atomic_load(p, __ATOMIC_RELAXED, __HIP_MEMORY_SCOPE_AGENT); }
__device__ __forceinline__ unsigned xb_add(unsigned* p, unsigned v) { return __hip_atomic_fetch_add(p, v, __ATOMIC_RELAXED, __HIP_MEMORY_SCOPE_AGENT); }
__device__ __forceinline__ unsigned xb_xcc_id() { return (unsigned)__builtin_amdgcn_s_getreg((3 << 11) | 20) & 0xFu; }
#define XB_SPIN(cond, bar) do { unsigned _sp = 0; while (cond) { __builtin_amdgcn_s_sleep(1); \
    if ((++_sp & 255u) == 0u) { if (xb_ld(&(bar)[XB_TMO])) break; if (_sp > XB_SPIN_CAP) { atomicAdd(&(bar)[XB_TMO], 1u); break; } } } } while (0)

struct XcdBarrier {
    unsigned* bar; unsigned x;
    volatile LAS unsigned* st;
};

__device__ __forceinline__ XcdBarrier xcd_barrier_post(unsigned* bar, volatile LAS unsigned* st) {
    XcdBarrier b; b.bar = bar; b.x = xb_xcc_id(); b.st = st;
    if (threadIdx.x == 0) (void)xb_add(&bar[XB_XCNT(b.x)], 1u);
    return b;
}
__device__ __forceinline__ void xcd_barrier_complete(unsigned* bar, unsigned x, unsigned& nloc, unsigned& nx) {
    const unsigned G = gridDim.x * gridDim.y * gridDim.z;
    unsigned sum, cnt, mine, sp = 0u;
    for (;;) {
        sum = 0u; cnt = 0u; mine = 0u;
#pragma unroll
        for (unsigned j = 0; j < 16; ++j) { const unsigned c = xb_ld(&bar[XB_XCNT(j)]); sum += c; cnt += (c > 0u) ? 1u : 0u; mine = (j == x) ? c : mine; }
        if (sum == G) break;
        __builtin_amdgcn_s_sleep(1);
        if ((++sp & 255u) == 0u) { if (xb_ld(&bar[XB_TMO])) break; if (sp > XB_SPIN_CAP) { atomicAdd(&bar[XB_TMO], 1u); break; } }
    }
    nloc = mine > 0u ? mine : 1u; nx = cnt > 0u ? cnt : 1u;
}

__device__ __forceinline__ void xcd_barrier(const XcdBarrier& b) {
    asm volatile("s_waitcnt vmcnt(0)" ::: "memory");
    __syncthreads();
    if (threadIdx.x == 0) {
        unsigned* bar = b.bar;
        __builtin_amdgcn_s_waitcnt(0);
        unsigned nloc = b.st[0], nx = b.st[1];
        if (nloc == 0u) { xcd_barrier_complete(bar, b.x, nloc, nx); b.st[0] = nloc; b.st[1] = nx; }
        const unsigned old = xb_add(&bar[XB_XSUB(b.x)], 1u);
        const unsigned gen = old / nloc;
        if (old + 1u == (gen + 1u) * nloc) {
            __builtin_amdgcn_fence(__ATOMIC_RELEASE, "agent");
            asm volatile("s_waitcnt vmcnt(0)" ::: "memory");
            const unsigned og = xb_add(&bar[XB_TOP], 1u);
            const unsigned tg = og / nx;
            if (og + 1u == (tg + 1u) * nx) xb_add(&bar[XB_TOPGEN], 1u);
            else XB_SPIN(xb_ld(&bar[XB_TOPGEN]) == tg, bar);
            __builtin_amdgcn_fence(__ATOMIC_ACQUIRE, "agent");
            xb_add(&bar[XB_XGEN(b.x)], 1u);
            asm volatile("s_waitcnt vmcnt(0)" ::: "memory");
        } else {
            XB_SPIN(xb_ld(&bar[XB_XGEN(b.x)]) == gen, bar);
            __builtin_amdgcn_fence(__ATOMIC_ACQUIRE, "agent");
            asm volatile("s_waitcnt vmcnt(0)" ::: "memory");
        }
    }
    __syncthreads();
}

struct Frame {
    LAS unsigned char* lds;
    int tid, lane, wave, vcu, G;
    const float *xp, *xs, *g1, *win, *qg, *kg, *wpool, *pscale, *wout, *g2, *wup, *wdn;
    float* out;
    bf16 *Win_t, *Wo_t, *Wup_t, *Wdn_t, *XN, *MIX, *KV, *U, *H;
    float *cosT, *sinT, *stats, *xinv;
};

__device__ __forceinline__ float wave_sum(float v) {
#pragma unroll
    for (int o = 1; o < 64; o <<= 1) v += __shfl_xor(v, o);
    return v;
}
__device__ __forceinline__ int inproj_dst_row(int A) {
    const int pn = A >> 8, a = A & 255;
    if (pn >= 3) return A;
    const int bj = (a >> 5) & 1, i = a & 31, head = a >> 6;
    int c;
    if (pn == 2 && a >= 128) c = 128 * bj + 32 * head + i;
    else c = 128 * bj + 32 * head + 8 * ((i >> 2) & 3) + 4 * (i >> 4) + (i & 3);
    return 256 * pn + c;
}
template <int MODE> __device__ __forceinline__ void p0_transpose_item(const float* W, int N, bf16* WT, int ldt, const float* kscale, LAS float* scr, int item, int lane) {
    const int nblk = N / 32, kb = item / nblk, nb = item % nblk, k0 = 64 * kb, n0 = 32 * nb;
#pragma unroll
    for (int i = 0; i < 32; ++i) { const int kk = 2 * i + (lane >> 5); float v = W[(size_t)(k0 + kk) * N + n0 + (lane & 31)]; if (kscale) v *= kscale[k0 + kk]; scr[kk * 33 + (lane & 31)] = v; }
    LDS_WAIT(); asm volatile("" ::: "memory");
    const int c = lane & 7;
#pragma unroll
    for (int j = 0; j < 4; ++j) { const int n = (lane >> 3) + 8 * j; const LAS float* s = scr + (8 * c) * 33 + n;
        v4u o; o.x = pk2(s[0 * 33], s[1 * 33]); o.y = pk2(s[2 * 33], s[3 * 33]); o.z = pk2(s[4 * 33], s[5 * 33]); o.w = pk2(s[6 * 33], s[7 * 33]);
        const int dr = MODE == 1 ? inproj_dst_row(n0 + n) : (n0 + n);
        *(GAS v4u*)(WT + (size_t)dr * ldt + k0 + 8 * c) = o; }
    LDS_WAIT(); asm volatile("" ::: "memory");
}
__device__ __forceinline__ void titem_load(const float* tW, int tN, int tr, int lane, float (&v)[32]) {
    const int nblk = tN / 32, kb = tr / nblk, nb = tr % nblk, k0 = 64 * kb, n0 = 32 * nb;
#pragma unroll
    for (int i = 0; i < 32; ++i) { const int kk = 2 * i + (lane >> 5); v[i] = tW[(size_t)(k0 + kk) * tN + n0 + (lane & 31)]; }
}
__device__ __forceinline__ void titem_store(int tN, bf16* tWT, int tldt, const float* tks, int tmode, int tr, LAS float* scr, int lane, const float (&v)[32]) {
    const int nblk = tN / 32, kb = tr / nblk, nb = tr % nblk, k0 = 64 * kb, n0 = 32 * nb;
#pragma unroll
    for (int i = 0; i < 32; ++i) { const int kk = 2 * i + (lane >> 5); float x = v[i]; if (tks) x *= tks[k0 + kk]; scr[kk * 33 + (lane & 31)] = x; }
    LDS_WAIT(); asm volatile("" ::: "memory");
    const int c = lane & 7;
#pragma unroll
    for (int j = 0; j < 4; ++j) { const int n = (lane >> 3) + 8 * j; const LAS float* sp = scr + (8 * c) * 33 + n;
        v4u o; o.x = pk2(sp[0 * 33], sp[1 * 33]); o.y = pk2(sp[2 * 33], sp[3 * 33]); o.z = pk2(sp[4 * 33], sp[5 * 33]); o.w = pk2(sp[6 * 33], sp[7 * 33]);
        const int dr = tmode == 1 ? inproj_dst_row(n0 + n) : (n0 + n);
        *(GAS v4u*)(tWT + (size_t)dr * tldt + k0 + 8 * c) = o; }
    LDS_WAIT(); asm volatile("" ::: "memory");
}
__device__ __forceinline__ void rms_row_to_bf16(Frame& F, const f32x4 (&v)[4], bf16* orow, float* xinv_row) {
    const GAS f32x4* gr = (const GAS f32x4*)F.g1 + 2 * F.lane;
    float s = 0.f;
#pragma unroll
    for (int j = 0; j < 4; ++j) { s += (v[j].x * v[j].x + v[j].y * v[j].y) + (v[j].z * v[j].z + v[j].w * v[j].w); }
    const float ms = wave_sum(s) * (1.f / D) + EPS, rstd = __builtin_amdgcn_rsqf(ms), rms = ms * rstd;
    if (F.lane == 0) *xinv_row = rms;
    GAS v4u* o16 = (GAS v4u*)orow + F.lane;
#pragma unroll
    for (int j = 0; j < 2; ++j) { const f32x4 ga = gr[128 * j], gb = gr[128 * j + 1]; const f32x4 ya = v[2 * j] * rstd * ga, yb = v[2 * j + 1] * rstd * gb;
        v4u o; o.x = pk2(ya.x, ya.y); o.y = pk2(ya.z, ya.w); o.z = pk2(yb.x, yb.y); o.w = pk2(yb.z, yb.w); o16[64 * j] = o; }
}
constexpr int P0_WW = 2;
__device__ __forceinline__ void p0_prologue(Frame& F) {
    LAS float* scr = (LAS float*)(F.lds + RING_OFF + F.wave * 16384);
    if (F.wave < P0_WW) {
    const int gw = F.vcu * P0_WW + F.wave, NGW = F.G * P0_WW;
    const int gt = gw * 64 + F.lane, NGT = NGW * 64;
    for (int it = gt; it < 2048; it += NGT) {
        const int pos = it >> 4, f = it & 15; double invf = 1.0;
        for (int i = 0; i < f; ++i) invf *= 0.5623413251903491;
        const double a = (double)pos * invf, k = __builtin_rint(a * 0.15915494309189535), r = a - k * 6.283185307179586, r2 = r * r;
        double s = 1.0, c = 1.0;
        for (int i = 16; i >= 1; --i) { s = 1.0 - s * r2 / (double)((2 * i) * (2 * i + 1)); c = 1.0 - c * r2 / (double)((2 * i - 1) * (2 * i)); }
        s *= r; F.cosT[it] = (float)c; F.sinT[it] = (float)s;
    }
    for (int it = gt; it < 128 * 1024; it += NGT) {
        const int jb = __builtin_amdgcn_readfirstlane(it >> 10), n = it & 1023, g = jb >> 5, jj0 = (jb & 31) * 4;
        const float* wp = F.wpool + ((size_t)g * 128 + jj0) * 128; const float* ps = F.pscale + g * 128; const float* wo = F.wout + (size_t)(512 + g * 128) * 1024 + n;
        float a0 = 0.f, a1 = 0.f, a2 = 0.f, a3 = 0.f;
        for (int e0 = 0; e0 < 128; e0 += 32) { float w[32];
#pragma unroll
            for (int i = 0; i < 32; ++i) w[i] = wo[(size_t)(e0 + i) * 1024];
#pragma unroll
            for (int i = 0; i < 32; ++i) { const float ww = w[i] * ps[e0 + i]; a0 += wp[0 * 128 + e0 + i] * ww; a1 += wp[1 * 128 + e0 + i] * ww; a2 += wp[2 * 128 + e0 + i] * ww; a3 += wp[3 * 128 + e0 + i] * ww; } }
        typedef unsigned v2u __attribute__((ext_vector_type(2)));
        v2u o; o.x = pk2(a0, a1); o.y = pk2(a2, a3);
        *(GAS v2u*)(F.Wo_t + (size_t)n * 1024 + 512 + jb * 4) = o;
    }
    constexpr int I_IN = (D / 64) * (NIN / 32), I_O = (512 / 64) * (D / 32), I_UP = (D / 64) * (FF / 32), I_DN = (FF / 64) * (D / 32);
    constexpr int NITEMS = I_IN + I_O + I_UP + I_DN;
#define P0_DECODE(p, it_) const float* p##W; int p##N; bf16* p##WT; int p##ldt; const float* p##ks; int p##mode; int p##r; { int r_ = (it_); \
        if (r_ < I_IN) { p##W = F.win; p##N = NIN; p##WT = F.Win_t; p##ldt = D; p##ks = nullptr; p##mode = 1; p##r = r_; } \
        else if (r_ < I_IN + I_O) { p##W = F.wout; p##N = D; p##WT = F.Wo_t; p##ldt = D; p##ks = nullptr; p##mode = 0; p##r = r_ - I_IN; } \
        else if (r_ < I_IN + I_O + I_UP) { p##W = F.wup; p##N = FF; p##WT = F.Wup_t; p##ldt = D; p##ks = F.g2; p##mode = 0; p##r = r_ - I_IN - I_O; } \
        else { p##W = F.wdn; p##N = D; p##WT = F.Wdn_t; p##ldt = FF; p##ks = nullptr; p##mode = 0; p##r = r_ - I_IN - I_O - I_UP; } }
    for (int it = gw; it < NITEMS; it += 2 * NGW) {
        const int it2 = it + NGW; const bool two = it2 < NITEMS;
        P0_DECODE(ta, it) P0_DECODE(tb, two ? it2 : it)
        float va[32], vb[32];
        titem_load(taW, taN, tar, F.lane, va); titem_load(tbW, tbN, tbr, F.lane, vb);
        titem_store(taN, taWT, taldt, taks, tamode, tar, scr, F.lane, va); if (two) titem_store(tbN, tbWT, tbldt, tbks, tbmode, tbr, scr, F.lane, vb);
    }
#undef P0_DECODE
    } else {
    const int gw = F.vcu * (NWAVES - P0_WW) + (F.wave - P0_WW), NGW = F.G * (NWAVES - P0_WW);
    for (int m = gw; m < M; m += 4 * NGW) {
        f32x4 v[4][4];
#pragma unroll
        for (int q = 0; q < 4; ++q) { const int mm = m + q * NGW; if (mm < M) { const float* xrow = mm < ROWS_P ? F.xp + (size_t)mm * D : F.xs + (size_t)(mm - ROWS_P) * D; const GAS f32x4* xr = (const GAS f32x4*)xrow + 2 * F.lane;
#pragma unroll
            for (int j = 0; j < 2; ++j) { v[q][2 * j] = __builtin_nontemporal_load(xr + 128 * j); v[q][2 * j + 1] = __builtin_nontemporal_load(xr + 128 * j + 1); } } else {
#pragma unroll
            for (int j = 0; j < 4; ++j) v[q][j] = (f32x4){0.f, 0.f, 0.f, 0.f}; } }
#pragma unroll
        for (int q = 0; q < 4; ++q) { const int mm = m + q * NGW; if (mm < M) rms_row_to_bf16(F, v[q], F.XN + (size_t)mm * D, F.xinv + mm); }
    }
    }
}

template <int HW> struct PoolItem {
    v4u w[8 + 2 * HW]; int S, t0, seq0, cc;
    __device__ __forceinline__ void load(Frame& F, int g, int rg, int lane) {
        const int row0 = rg * 32 + (lane >> 4) * 8; cc = g * 16 + (lane & 15);
        if (row0 < ROWS_P) { S = 4096; t0 = row0 & 4095; } else { S = 8192; t0 = (row0 - ROWS_P) & 8191; }
        seq0 = row0 - t0;
        const GAS v4u* ub = (const GAS v4u*)(F.U + (size_t)seq0 * 512 + cc * 8);
#pragma unroll
        for (int k = 0; k < 8 + 2 * HW; ++k) { const int j = t0 - HW + k; w[k] = (j >= 0 && j < S) ? ub[(size_t)j * 64] : (v4u){0u, 0u, 0u, 0u}; }
    }
    __device__ __forceinline__ void finish(Frame& F) {
        float s0 = 0.f, s1 = 0.f, s2 = 0.f, s3 = 0.f, s4 = 0.f, s5 = 0.f, s6 = 0.f, s7 = 0.f;
#pragma unroll
        for (int k = 0; k < 2 * HW; ++k) { s0 += bflo(w[k].x); s1 += bfhi(w[k].x); s2 += bflo(w[k].y); s3 += bfhi(w[k].y); s4 += bflo(w[k].z); s5 += bfhi(w[k].z); s6 += bflo(w[k].w); s7 += bfhi(w[k].w); }
#pragma unroll
        for (int r = 0; r < 8; ++r) {
            const int t = t0 + r, lo = t - HW < 0 ? 0 : t - HW, hi = t + HW > S ? S : t + HW; const float inv = __builtin_amdgcn_rcpf((float)(hi - lo));
            const v4u c = w[r + HW];
            v4u o; o.x = pk2(s0 * inv - bflo(c.x), s1 * inv - bfhi(c.x)); o.y = pk2(s2 * inv - bflo(c.y), s3 * inv - bfhi(c.y)); o.z = pk2(s4 * inv - bflo(c.z), s5 * inv - bfhi(c.z)); o.w = pk2(s6 * inv - bflo(c.w), s7 * inv - bfhi(c.w));
            *(GAS v4u*)(F.MIX + (size_t)(seq0 + t) * 1024 + 512 + cc * 8) = o;
            if (r < 7) { const v4u a = w[r + 2 * HW], b = w[r];
                s0 += bflo(a.x) - bflo(b.x); s1 += bfhi(a.x) - bfhi(b.x); s2 += bflo(a.y) - bflo(b.y); s3 += bfhi(a.y) - bfhi(b.y); s4 += bflo(a.z) - bflo(b.z); s5 += bfhi(a.z) - bfhi(b.z); s6 += bflo(a.w) - bflo(b.w); s7 += bfhi(a.w) - bfhi(b.w); }
        }
    }
};
template <int HW> __device__ __forceinline__ void pool_wave(Frame& F, int g, int first, int stride) {
    constexpr int NRG = M / 32;
    if (HW <= 4 && first + 2 * stride < NRG && first + 3 * stride >= NRG) {
        PoolItem<HW> a, b; a.load(F, g, first, F.lane); b.load(F, g, first + stride, F.lane);
        a.finish(F); a.load(F, g, first + 2 * stride, F.lane); b.finish(F); a.finish(F);
    } else {
        for (int rg = first; rg < NRG; rg += stride) { PoolItem<HW> a; a.load(F, g, rg, F.lane); a.finish(F); }
    }
}
__device__ __forceinline__ void pool_role_big(Frame& F, int idx) { constexpr int NRG = M / 32;
    { PoolItem<8> a; a.load(F, 3, idx, F.lane); a.finish(F); }
    { PoolItem<8> b; b.load(F, 3, idx + NRG / 2, F.lane); b.finish(F); } }
__device__ __forceinline__ void pool_role_mid(Frame& F, int idx) { constexpr int NRG = M / 32;
    PoolItem<4> a, b, c; a.load(F, 2, idx, F.lane); b.load(F, 2, idx + NRG / 3, F.lane); a.finish(F); c.load(F, 2, idx + 2 * (NRG / 3), F.lane); b.finish(F); c.finish(F); }
__device__ __forceinline__ void pool_role_small(Frame& F, int idx) { constexpr int NRG = M / 32;
    PoolItem<2> a1, b1; PoolItem<1> a0, b0;
    a1.load(F, 1, idx, F.lane); b1.load(F, 1, idx + NRG / 2, F.lane); a1.finish(F); a0.load(F, 0, idx, F.lane); b1.finish(F); b0.load(F, 0, idx + NRG / 2, F.lane); a0.finish(F); b0.finish(F); }
__device__ __forceinline__ void pool_pass(Frame& F) {
    if (F.G == 256) {
        const int w = F.wave;
        if (w < 3) pool_role_big(F, F.vcu * 3 + w); else if (w < 5) pool_role_mid(F, F.vcu * 2 + (w - 3)); else pool_role_small(F, F.vcu * 3 + (w - 5));
        return;
    }
    const int gw = F.vcu * NWAVES + F.wave, NGW = F.G * NWAVES;
    const int g = gw & 3, first = gw >> 2, stride = NGW >> 2;
    if (g == 0) pool_wave<1>(F, 0, first, stride); else if (g == 1) pool_wave<2>(F, 1, first, stride); else if (g == 2) pool_wave<4>(F, 2, first, stride); else pool_wave<8>(F, 3, first, stride);
}

__device__ __forceinline__ void attn_decode(int L, long& rowbase, int& NT, int& h, int& qb, int& kvh) {
    const int i = L >> 8, v = L & 255, xcd = v >> 5, l = v & 31;
    if (i < 4) { const int combo = xcd * 2 + (i >> 1), b = combo >> 1; kvh = combo & 1; const int idx = (i & 1) * 32 + l; h = kvh * 4 + (idx >> 4); qb = idx & 15; rowbase = (long)b * 4096; NT = 64; }
    else { const int combo = xcd >> 1, b = combo >> 1; kvh = combo & 1; const int idx = (xcd & 1) * 64 + (i - 4) * 32 + l; h = kvh * 4 + (idx >> 5); qb = idx & 31; rowbase = (long)ROWS_P + (long)b * 8192; NT = 128; }
}
template <bool NOMAX> __device__ __forceinline__ void attn_all_t(Frame& F, char* lds, bf16* Obuf) {
    attn_body::bf16x8 qr[4] = {};
    bool first = true;
    for (int L = F.vcu; L < 1536; L += F.G) {
        long rowbase, n_rowbase; int NT, h, qb, kvh, n_NT, n_h, n_qb, n_kvh;
        attn_decode(L, rowbase, NT, h, qb, kvh);
        const bool has_next = L + F.G < 1536;
        attn_decode(has_next ? L + F.G : L, n_rowbase, n_NT, n_h, n_qb, n_kvh);
        const attn_body::bf16* Kh = (const attn_body::bf16*)F.KV + rowbase * 256 + kvh * 64;
        const attn_body::bf16* n_Kh = (const attn_body::bf16*)F.KV + n_rowbase * 256 + n_kvh * 64;
        attn_body::attn_unit<8, NOMAX>(rowbase, NT, h, qb, (const attn_body::bf16*)F.MIX, Kh, Kh + 128, (attn_body::bf16*)Obuf, lds, first, has_next, n_rowbase, n_h, n_qb, n_Kh, qr);
        first = false;
    }
}
__device__ __forceinline__ void attn_all(Frame& F, char* lds, bf16* Obuf) {
    float mq = 0.f, mk = 0.f;
    for (int i = 0; i < 64; ++i) { mq = fmaxf(mq, fabsf(F.qg[i])); mk = fmaxf(mk, fabsf(F.kg[i])); }
    const bool fast = 2.0f * (8.0f * 1.4426950408889634f) * mq * mk < 64.0f;
    if (fast) attn_all_t<true>(F, lds, Obuf); else attn_all_t<false>(F, lds, Obuf);
}

struct Args { const float* in[12]; float* out; unsigned char* ws; int ph_lo, ph_hi; };
__global__ void __launch_bounds__(NWAVES * 64, 2) mega_fwd(Args args) {
    extern __shared__ __attribute__((aligned(16))) unsigned char lds[];
    Frame F;
    F.lds = (LAS unsigned char*)lds;
    F.tid = threadIdx.x; F.lane = F.tid & 63; F.wave = __builtin_amdgcn_readfirstlane(F.tid >> 6);
    F.G = gridDim.x; { const int bx = blockIdx.x; F.vcu = (F.G % 8 == 0) ? (bx % 8) * (F.G / 8) + bx / 8 : bx; }
    unsigned char* ws = args.ws;
    F.xp = args.in[0]; F.xs = args.in[1]; F.g1 = args.in[2]; F.win = args.in[3]; F.qg = args.in[4]; F.kg = args.in[5]; F.wpool = args.in[6]; F.pscale = args.in[7];
    F.wout = args.in[8]; F.g2 = args.in[9]; F.wup = args.in[10]; F.wdn = args.in[11]; F.out = args.out;
    F.Win_t = (bf16*)(ws + WS_WIN); F.Wo_t = (bf16*)(ws + WS_WO); F.Wup_t = (bf16*)(ws + WS_WUP); F.Wdn_t = (bf16*)(ws + WS_WDN);
    F.XN = (bf16*)(ws + WS_XN); F.MIX = (bf16*)(ws + WS_MIX); F.KV = (bf16*)(ws + WS_KV); F.U = (bf16*)(ws + WS_U); F.H = (bf16*)(ws + WS_H);
    F.cosT = (float*)(ws + WS_ROPE); F.sinT = F.cosT + 2048; F.stats = (float*)(ws + WS_STATS); F.xinv = (float*)(ws + WS_XINV);
#if MK_N_LAUNCHES == 1
    cg::grid_group grid = cg::this_grid();
    for (int u = F.tid; u < (LDS_BYTES - LDSCTL_OFF) / 4; u += NWAVES * 64) ((LAS unsigned*)(F.lds + LDSCTL_OFF))[u] = 0u;
    __syncthreads();
    XcdBarrier bar = xcd_barrier_post((unsigned*)(ws + WS_CTL), (volatile LAS unsigned*)(F.lds + MISC_OFF) + 8);
#define GRID_BAR() do { if (args.ph_hi < 0) { asm volatile("s_waitcnt vmcnt(0)" ::: "memory"); grid.sync(); } else xcd_barrier(bar); } while (0)
#define GRID_BAR0() GRID_BAR()
#else
#define GRID_BAR0() do {} while (0)
#define GRID_BAR() do {} while (0)
#endif
    const int lo = args.ph_lo, hi = args.ph_hi < 0 ? -args.ph_hi : args.ph_hi;
#define IN(k) (lo <= (k) && (k) < hi)
#define BOTH(k) (IN(k) && IN((k) + 1))
    if (IN(0)) { p0_prologue(F);
#if PROBE_PH == 0
        p0_prologue(F);
#endif
        if (BOTH(0)) GRID_BAR0(); }
    if (IN(1)) {
        pg8::Gemm g{F.XN, F.Win_t, M, NIN, D}; pg8::StaticOrder S; S.init(M, NIN, F.G, (int)blockIdx.x);
        pg8::EpiInProj E{F.MIX, F.KV, F.U, F.qg, F.kg, F.cosT, F.sinT};
        pg8::gemm_phase<pg8::EpiInProj, pg8::StaticOrder, PG8_ALIGN, PG8_SP2>(F.lds + RING_OFF, g, S, E);
#if PROBE_PH == 1
        pg8::gemm_phase<pg8::EpiInProj, pg8::StaticOrder, PG8_ALIGN, PG8_SP2>(F.lds + RING_OFF, g, S, E);
#endif
        if (BOTH(1)) GRID_BAR();
    }
    if (IN(2)) {
        static_assert(attn_body::ATTN_LDS_BYTES <= RING_BYTES, "attention LDS");
        pool_pass(F);
#if PROBE_PH == 2
        attn_all(F, (char*)lds + RING_OFF, F.XN);
#endif
#if PROBE_PH == 7
        pool_pass(F);
#endif
        attn_all(F, (char*)lds + RING_OFF, F.MIX);
        if (BOTH(2)) GRID_BAR();
    }
    if (IN(3)) {
        pg8::Gemm g{F.MIX, F.Wo_t, M, D, D}; pg8::StaticOrder S; S.init(M, D, F.G, (int)blockIdx.x);
        const int g_ok = __syncthreads_and((fabsf(F.g1[F.tid]) >= 1e-3f && fabsf(F.g1[F.tid + 512]) >= 1e-3f) ? 1 : 0);
        if (g_ok) { pg8::EpiResStats<true> E{F.xp, F.xs, F.XN, F.stats, F.xinv, F.g1};
            pg8::gemm_phase<pg8::EpiResStats<true>, pg8::StaticOrder, PG8_ALIGN, PG8_SP2>(F.lds + RING_OFF, g, S, E); }
        else { pg8::EpiResStats<false> E{F.xp, F.xs, F.XN, F.stats, F.xinv, F.g1};
            pg8::gemm_phase<pg8::EpiResStats<false>, pg8::StaticOrder, PG8_ALIGN, PG8_SP2>(F.lds + RING_OFF, g, S, E); }
        if (BOTH(3)) GRID_BAR();
    }
    if (IN(4)) {
        pg8::Gemm g{F.XN, F.Wup_t, M, FF, D}; pg8::StaticOrder S; S.init(M, FF, F.G, (int)blockIdx.x);
        LAS float* tab = (LAS float*)(F.lds + UPTAB_OFF);
        { const int rowi = F.tid & 255;
          for (int i = F.tid >> 8; i < pg8::UP_TAB_ROUNDS; i += 2) { const int pm = S.pm_at(i); if (pm < 0) break;
              const f32x4* p = (const f32x4*)(F.stats + (size_t)(pm * 256 + rowi) * 16); const f32x4 a = p[0], b = p[1], c = p[2], d = p[3];
              const float ssum = ((a[0] + a[1]) + (a[2] + a[3])) + ((b[0] + b[1]) + (b[2] + b[3])) + ((c[0] + c[1]) + (c[2] + c[3])) + ((d[0] + d[1]) + (d[2] + d[3]));
              tab[i * 256 + rowi] = __builtin_amdgcn_rsqf(ssum * (1.0f / 1024.0f) + EPS); }
          __syncthreads(); }
        pg8::EpiUp E{F.H, F.stats, tab};
        pg8::gemm_phase<pg8::EpiUp, pg8::StaticOrder, PG8_ALIGN, PG8_SP2>(F.lds + RING_OFF, g, S, E);
#if PROBE_PH == 4
        pg8::gemm_phase<pg8::EpiUp, pg8::StaticOrder, PG8_ALIGN, PG8_SP2>(F.lds + RING_OFF, g, S, E);
#endif
        if (BOTH(4)) GRID_BAR();
    }
    if (IN(5)) {
        pg8::Gemm g{F.H, F.Wdn_t, M, D, FF}; pg8::StaticOrder S; S.init(M, D, F.G, (int)blockIdx.x, 1);
        pg8::EpiDown E{F.out, F.XN};
        pg8::gemm_phase<pg8::EpiDown, pg8::StaticOrder, PG8_ALIGN, PG8_SP2>(F.lds + RING_OFF, g, S, E);
#if PROBE_PH == 5
        pg8::gemm_phase<pg8::EpiDown, pg8::StaticOrder, PG8_ALIGN, PG8_SP2>(F.lds + RING_OFF, g, S, E);
#endif
    }
#undef IN
#undef BOTH
}

extern "C" void kernel_launch(void* const* d_in, const int* in_sizes, int n_in, void* d_out, int out_size, void* d_ws, size_t ws_size, hipStream_t stream) {
    static int grid = 0;
    if (grid == 0) {
        if (n_in != 12 || in_sizes[0] != ROWS_P * D || in_sizes[1] != (M - ROWS_P) * D || out_size != M * D || ws_size < WS_END) {
            fprintf(stderr, "kernel_launch: shape / workspace mismatch (n_in %d, out %d, ws %zu < %zu); nothing launched\n", n_in, out_size, ws_size, (size_t)WS_END); grid = -1; return; }
        int dev = 0, cus = 0, per_cu = 0;
        if (hipGetDevice(&dev) != hipSuccess || hipDeviceGetAttribute(&cus, hipDeviceAttributeMultiprocessorCount, dev) != hipSuccess) { grid = -1; return; }
        if (hipFuncSetAttribute((const void*)mega_fwd, hipFuncAttributeMaxDynamicSharedMemorySize, LDS_BYTES) != hipSuccess) { fprintf(stderr, "kernel_launch: hipFuncSetAttribute failed\n"); grid = -1; return; }
        if (hipOccupancyMaxActiveBlocksPerMultiprocessor(&per_cu, (const void*)mega_fwd, NWAVES * 64, LDS_BYTES) != hipSuccess || per_cu < 1) { fprintf(stderr, "kernel_launch: occupancy query says %d\n", per_cu); per_cu = 1; }
        (void)hipGetLastError();
        grid = cus * per_cu;
    }
    if (grid < 0) return;
    Args a{};
    for (int i = 0; i < 12; ++i) a.in[i] = (const float*)d_in[i];
    a.out = (float*)d_out; a.ws = (unsigned char*)d_ws;
#if MK_N_LAUNCHES == 1
    a.ph_lo = 0; a.ph_hi = PER_PHASE;
    if (hipMemsetAsync((char*)d_ws + WS_CTL, 0, CTL_ZERO_BYTES, stream) != hipSuccess) { fprintf(stderr, "kernel_launch: memset of the barrier words failed\n"); return; }
    void* kargs[] = {&a};
    hipError_t e = hipLaunchCooperativeKernel((const void*)mega_fwd, dim3(grid), dim3(NWAVES * 64), kargs, LDS_BYTES, stream);
    if (e != hipSuccess) fprintf(stderr, "kernel_launch: cooperative launch failed: %s (grid %d)\n", hipGetErrorString(e), grid);
#else
    for (int li = 0; li < PER_PHASE; ++li) { a.ph_lo = li; a.ph_hi = li + 1; hipLaunchKernelGGL(mega_fwd, dim3(grid), dim3(NWAVES * 64), LDS_BYTES, stream, a); }
#endif
}
```

```cpp
#define MK_N_LAUNCHES 1
#include <hip/hip_runtime.h>
#include <hip/hip_cooperative_groups.h>
#include <cstdio>
#include <cstdint>
namespace cg = cooperative_groups;
namespace pg8 {
#define PG8_LAS __attribute__((address_space(3)))
typedef unsigned short bf16_t;
typedef short bf16x8 __attribute__((ext_vector_type(8)));
typedef float f32x4 __attribute__((ext_vector_type(4)));
typedef unsigned u32x4 __attribute__((ext_vector_type(4)));
constexpr int BM = 256, BK = 64, HALF = 128, HTB = HALF * BK * 2  , STAGE_BYTES = 8 * HTB, NXCD = 8, WGM = 8;

__host__ __device__ __forceinline__ int lds_byte(int r, int c) { const int st = (r >> 4) * 2 + (c >> 5), rr = r & 15, cc = c & 31, ob = rr * 64 + cc * 2; return st * 1024 + (ob ^ (((ob >> 9) & 1) << 5)); }
__host__ __device__ __forceinline__ void stage_rc(int b, int& R, int& C) { const int st = b / 1024, sb = b % 1024, swz = sb ^ (((sb >> 9) & 1) << 5); R = (st >> 1) * 16 + swz / 64; C = (st & 1) * 32 + (swz % 64) / 2; }
__host__ __device__ __forceinline__ int perm32(int rho) { const int n = rho >> 4, i = rho & 15; return 8 * (i >> 2) + 4 * n + (i & 3); }

struct Unit { int pm, pn, idx; };
struct Gemm { const bf16_t* A; const bf16_t* Bt; int M, N, K; };

struct StaticOrder {
    int nM, nN, nwg, G, c, R, rev;
    __host__ __device__ void init(int M, int N, int G_, int c_, int rev_ = 0) { nM = M / BM; nN = N / BM; nwg = nM * nN; G = G_; c = c_; R = (nwg + G - 1) / G; rev = rev_; }
    __host__ __device__ bool next(int i, Unit& u) const {
        if (i >= R) return false;
        const long L = (long)(rev ? R - 1 - i : i) * G + c; if (L >= nwg) return false;
        int wgid = (int)L; { const int q = nwg / NXCD, r = nwg % NXCD, xcd = wgid % NXCD, off = wgid / NXCD; wgid = (xcd < r ? xcd * (q + 1) : r * (q + 1) + (xcd - r) * q) + off; }
        const int nig = WGM * nN, gid = wgid / nig, fm = gid * WGM, gsz = (nM - fm) < WGM ? (nM - fm) : WGM;
        u.pm = fm + ((wgid % nig) % gsz); u.pn = (wgid % nig) / gsz; u.idx = i; return true;
    }
    __device__ __forceinline__ int pm_at(int i) const {
        if (i >= R) return -1;
        const long L = (long)(rev ? R - 1 - i : i) * G + c; if (L >= nwg) return -1;
        int wgid = (int)L; { const int q = nwg / NXCD, r = nwg % NXCD, xcd = wgid % NXCD, off = wgid / NXCD; wgid = (xcd < r ? xcd * (q + 1) : r * (q + 1) + (xcd - r) * q) + off; }
        const int nig = WGM * nN, gid = wgid / nig, fm = gid * WGM, gsz = (nM - fm) < WGM ? (nM - fm) : WGM;
        return fm + ((wgid % nig) % gsz);
    }
    __device__ __forceinline__ void a_ready(const Unit&) const {}
    __device__ __forceinline__ void done(const Unit&) const {}
};

__device__ __forceinline__ unsigned cvt_pk_bf16(float lo, float hi) { unsigned r; asm volatile("v_cvt_pk_bf16_f32 %0, %1, %2" : "=v"(r) : "v"(lo), "v"(hi)); return r; }

typedef float f32x2 __attribute__((ext_vector_type(2)));
typedef unsigned u32x2 __attribute__((ext_vector_type(2)));
constexpr int ROWS_PROMPT = 8 * 4096;
constexpr float RMS_EPS = 1e-6f;
constexpr float QK_C2 = 0.125f * 1.4426950408889634f;

struct EpiInProj {
    static constexpr bool PERM = true, AFTER_DRAIN = false;
    bf16_t* MIX; bf16_t* KV; bf16_t* U; const float* qg; const float* kg; const float* cosT; const float* sinT;
    __device__ __forceinline__ void operator()(const f32x4 (&acc)[2][2][4][2], const Unit& u, int wr, int wc, int fr, int fq) const {
        const int row0 = u.pm * BM + wr * 64 + fr;
        if (u.pn >= 3 || (u.pn == 2 && wc >= 2)) {
            bf16_t* base; int pitch;
            if (u.pn >= 3) { base = U + (size_t)row0 * 512 + (u.pn - 3) * 256 + wc * 32 + 8 * fq; pitch = 512; }
            else { base = KV + (size_t)row0 * 256 + 128 + (wc - 2) * 64 + 8 * fq; pitch = 256; }
            const int bjs = (u.pn >= 3) ? HALF : 32;
#pragma unroll
            for (int ai = 0; ai < 2; ++ai)
#pragma unroll
                for (int m = 0; m < 4; ++m) { bf16_t* rowp = base + (size_t)(ai * HALF + m * 16) * pitch;
#pragma unroll
                    for (int bj = 0; bj < 2; ++bj) { const f32x4 v0 = acc[ai][bj][m][0], v1 = acc[ai][bj][m][1];
                        u32x4 w; w.x = cvt_pk_bf16(v0[0], v0[1]); w.y = cvt_pk_bf16(v0[2], v0[3]); w.z = cvt_pk_bf16(v1[0], v1[1]); w.w = cvt_pk_bf16(v1[2], v1[3]);
                        *(u32x4*)(rowp + bj * bjs) = w; } }
            return;
        }
        const bool isK = (u.pn == 2);
        const float* g = isK ? kg : qg; const float sc = isK ? 1.f : QK_C2;
        bf16_t* base; int pitch;
        if (isK) { base = KV + (size_t)row0 * 256 + wc * 64 + 8 * fq; pitch = 256; } else { base = MIX + (size_t)row0 * 1024 + (u.pn * 4 + wc) * 64 + 8 * fq; pitch = 1024; }
        f32x4 gv[2][2];
#pragma unroll
        for (int bj = 0; bj < 2; ++bj)
#pragma unroll
            for (int n = 0; n < 2; ++n) gv[bj][n] = *(const f32x4*)(g + 32 * bj + 16 * n + 4 * fq) * sc;
        const int rowt = u.pm * BM; const int t0 = rowt < ROWS_PROMPT ? (rowt & 4095) : ((rowt - ROWS_PROMPT) & 8191);
        const int prow_base = (t0 >> 6) + wr;
#pragma unroll
        for (int ai = 0; ai < 2; ++ai) {
            const int prow = prow_base + 2 * ai;
            const f32x4 cr = *(const f32x4*)(cosT + prow * 16 + 4 * fq), sr = *(const f32x4*)(sinT + prow * 16 + 4 * fq);
#pragma unroll
            for (int m = 0; m < 4; ++m) {
                const int pcol = 16 * m + fr;
                const f32x4 cc = *(const f32x4*)(cosT + pcol * 16 + 4 * fq), sn = *(const f32x4*)(sinT + pcol * 16 + 4 * fq);
                float ss = 0.f;
#pragma unroll
                for (int bj = 0; bj < 2; ++bj)
#pragma unroll
                    for (int n = 0; n < 2; ++n) { const f32x4 x = acc[ai][bj][m][n]; ss += (x[0] * x[0] + x[1] * x[1]) + (x[2] * x[2] + x[3] * x[3]); }
                ss += __shfl_xor(ss, 16); ss += __shfl_xor(ss, 32);
                const float rstd = __builtin_amdgcn_rsqf(ss * (1.0f / 64.0f) + RMS_EPS);
                bf16_t* rowp = base + (size_t)(ai * HALF + m * 16) * pitch;
#pragma unroll
                for (int bj = 0; bj < 2; ++bj) { const f32x4 c = bj == 0 ? cr : cc, s = bj == 0 ? sr : sn;
                    const f32x4 y0 = acc[ai][bj][m][0] * rstd * gv[bj][0], y1 = acc[ai][bj][m][1] * rstd * gv[bj][1];
                    const f32x4 o0 = y0 * c - y1 * s, o1 = y1 * c + y0 * s;
                    u32x4 w; w.x = cvt_pk_bf16(o0[0], o0[1]); w.y = cvt_pk_bf16(o0[2], o0[3]); w.z = cvt_pk_bf16(o1[0], o1[1]); w.w = cvt_pk_bf16(o1[2], o1[3]);
                    *(u32x4*)(rowp + bj * 32) = w; }
            }
        }
    }
};

template <bool RECON> struct EpiResStats {
    static constexpr bool PERM = true, AFTER_DRAIN = false;
    const float* xp; const float* xs; bf16_t* xb; float* stats; const float* xinv; const float* g1;
    __device__ __forceinline__ void operator()(const f32x4 (&acc)[2][2][4][2], const Unit& u, int wr, int wc, int fr, int fq) const {
        const int rowt = u.pm * BM; const float* base = rowt < ROWS_PROMPT ? xp : xs - (size_t)ROWS_PROMPT * 1024;
        const int col0 = u.pn * BM + wc * 32 + 8 * fq;
        f32x4 gi[2][2];
        if constexpr (RECON) {
#pragma unroll
            for (int bj = 0; bj < 2; ++bj)
#pragma unroll
                for (int n = 0; n < 2; ++n) { const f32x4 g = *(const f32x4*)(g1 + col0 + bj * HALF + n * 4); gi[bj][n] = (f32x4){__builtin_amdgcn_rcpf(g[0]), __builtin_amdgcn_rcpf(g[1]), __builtin_amdgcn_rcpf(g[2]), __builtin_amdgcn_rcpf(g[3])}; }
        }
#pragma unroll
        for (int ai = 0; ai < 2; ++ai)
#pragma unroll
            for (int m = 0; m < 4; ++m) { const int r = rowt + ai * HALF + wr * 64 + m * 16 + fr; const size_t off = (size_t)r * 1024 + col0; float ss = 0.f;
                float xi = 0.f; if constexpr (RECON) xi = xinv[r];
#pragma unroll
                for (int bj = 0; bj < 2; ++bj) { f32x4 b0, b1;
                    if constexpr (RECON) { const u32x4 w = *(const u32x4*)(xb + off + bj * HALF);
                        b0 = (f32x4){__builtin_bit_cast(float, w.x << 16), __builtin_bit_cast(float, w.x & 0xffff0000u), __builtin_bit_cast(float, w.y << 16), __builtin_bit_cast(float, w.y & 0xffff0000u)} * xi * gi[bj][0];
                        b1 = (f32x4){__builtin_bit_cast(float, w.z << 16), __builtin_bit_cast(float, w.z & 0xffff0000u), __builtin_bit_cast(float, w.w << 16), __builtin_bit_cast(float, w.w & 0xffff0000u)} * xi * gi[bj][1]; }
                    else { b0 = *(const f32x4*)(base + off + bj * HALF); b1 = *(const f32x4*)(base + off + bj * HALF + 4); }
                    const f32x4 o0 = b0 + acc[ai][bj][m][0], o1 = b1 + acc[ai][bj][m][1];
                    ss += ((o0[0] * o0[0] + o0[1] * o0[1]) + (o0[2] * o0[2] + o0[3] * o0[3])) + ((o1[0] * o1[0] + o1[1] * o1[1]) + (o1[2] * o1[2] + o1[3] * o1[3]));
                    u32x4 w2; w2.x = cvt_pk_bf16(o0[0], o0[1]); w2.y = cvt_pk_bf16(o0[2], o0[3]); w2.z = cvt_pk_bf16(o1[0], o1[1]); w2.w = cvt_pk_bf16(o1[2], o1[3]); *(u32x4*)(xb + off + bj * HALF) = w2; }
                ss += __shfl_xor(ss, 16); ss += __shfl_xor(ss, 32);
                if (fq == 0) stats[(size_t)r * 16 + u.pn * 4 + wc] = ss;
                if (!RECON && m == 3) asm volatile("" ::: "memory"); }
    }
};

constexpr int UP_TAB_ROUNDS = 12;
struct EpiUp {
    static constexpr bool PERM = true, AFTER_DRAIN = false;
    bf16_t* H; const float* stats; const PG8_LAS float* tab;
    __device__ __forceinline__ void operator()(const f32x4 (&acc)[2][2][4][2], const Unit& u, int wr, int wc, int fr, int fq) const {
        const int row0 = u.pm * BM + wr * 64 + fr; const int col0 = u.pn * BM + wc * 32 + 8 * fq;
#pragma unroll
        for (int ai = 0; ai < 2; ++ai)
#pragma unroll
            for (int m = 0; m < 4; ++m) { const int r = row0 + ai * HALF + m * 16;
                float rstd;
                if (u.idx < UP_TAB_ROUNDS) rstd = tab[u.idx * BM + ai * HALF + wr * 64 + m * 16 + fr];
                else { const f32x4 p = *(const f32x4*)(stats + (size_t)r * 16 + 4 * fq); float s = (p[0] + p[1]) + (p[2] + p[3]);
                    s += __shfl_xor(s, 16); s += __shfl_xor(s, 32); rstd = __builtin_amdgcn_rsqf(s * (1.0f / 1024.0f) + RMS_EPS); }
                bf16_t* rowp = H + (size_t)r * 4096 + col0;
#pragma unroll
                for (int bj = 0; bj < 2; ++bj) { f32x4 v0 = acc[ai][bj][m][0] * rstd, v1 = acc[ai][bj][m][1] * rstd;
#pragma unroll
                    for (int e = 0; e < 4; ++e) { const float a = fmaxf(v0[e], 0.f), b = fmaxf(v1[e], 0.f); v0[e] = a * a; v1[e] = b * b; }
                    u32x4 w; w.x = cvt_pk_bf16(v0[0], v0[1]); w.y = cvt_pk_bf16(v0[2], v0[3]); w.z = cvt_pk_bf16(v1[0], v1[1]); w.w = cvt_pk_bf16(v1[2], v1[3]);
                    *(u32x4*)(rowp + bj * HALF) = w; } }
    }
};

struct EpiDown {
    static constexpr bool PERM = true, AFTER_DRAIN = false;
    float* out; const bf16_t* xb;
    __device__ __forceinline__ void operator()(const f32x4 (&acc)[2][2][4][2], const Unit& u, int wr, int wc, int fr, int fq) const {
        const int col0 = u.pn * BM + wc * 32 + 8 * fq;
#pragma unroll
        for (int ai = 0; ai < 2; ++ai)
#pragma unroll
            for (int m = 0; m < 4; ++m) { const int r = u.pm * BM + ai * HALF + wr * 64 + m * 16 + fr; const size_t off = (size_t)r * 1024 + col0;
#pragma unroll
                for (int bj = 0; bj < 2; ++bj) { const u32x4 w = __builtin_nontemporal_load((const u32x4*)(xb + off + bj * HALF));
                    const f32x4 b0 = {__builtin_bit_cast(float, w.x << 16), __builtin_bit_cast(float, w.x & 0xffff0000u), __builtin_bit_cast(float, w.y << 16), __builtin_bit_cast(float, w.y & 0xffff0000u)};
                    const f32x4 b1 = {__builtin_bit_cast(float, w.z << 16), __builtin_bit_cast(float, w.z & 0xffff0000u), __builtin_bit_cast(float, w.w << 16), __builtin_bit_cast(float, w.w & 0xffff0000u)};
                    __builtin_nontemporal_store(b0 + acc[ai][bj][m][0], (f32x4*)(out + off + bj * HALF)); __builtin_nontemporal_store(b1 + acc[ai][bj][m][1], (f32x4*)(out + off + bj * HALF + 4)); } }
    }
};

template <class Epi, class Sched, bool ALIGN_EPI = false, bool SP2 = false>
__device__ __forceinline__ void gemm_phase(PG8_LAS unsigned char* lds, const Gemm g, const Sched& S, const Epi& E) {
    const int tid = threadIdx.x, wid = __builtin_amdgcn_readfirstlane(tid >> 6), lane = tid & 63, wr = wid >> 2, wc = wid & 3, fr = lane & 15, fq = lane >> 4;
    const int K = g.K, nt = K / BK;
    unsigned voffA[2], voffB[2];
#pragma unroll
    for (int i = 0; i < 2; ++i) { int R, C; stage_rc(tid * 16 + i * 8192, R, C); const int Rb = Epi::PERM ? ((R & ~31) + perm32(R & 31)) : R;
        voffA[i] = (unsigned)(R * K + C) * 2u; voffB[i] = (unsigned)(Rb * K + C) * 2u; }
    const size_t kstep = (size_t)(BK * 2);
    const size_t hstep = (size_t)HALF * K * 2;
    const size_t tstep = 2 * hstep;
    const unsigned ldsw = (unsigned)wid * 1024u;
    const int aoff = lds_byte(wr * 64 + fr, fq * 8), boff = lds_byte(wc * 32 + fr, fq * 8);
#define PG8_SA(b, h) (((b) * 2 + (h)) * HTB)
#define PG8_SB(b, h) ((4 + (b) * 2 + (h)) * HTB)
#define PG8_STAGE(bufoff, gbase, voff) do { _Pragma("unroll") for (int _i = 0; _i < 2; ++_i) \
        __builtin_amdgcn_global_load_lds((const unsigned*)((const char*)(gbase) + (voff)[_i]), (PG8_LAS unsigned*)(lds + (bufoff) + ldsw + _i * 8192), 16, 0, 0); } while (0)
#define PG8_LDA(dst, b, h) do { _Pragma("unroll") for (int m = 0; m < 4; ++m) _Pragma("unroll") for (int k = 0; k < 2; ++k) dst[m][k] = *(const PG8_LAS bf16x8*)(lds + PG8_SA(b, h) + aoff + m * 2048 + k * 1024); } while (0)
#define PG8_LDB(dst, b, h) do { _Pragma("unroll") for (int n = 0; n < 2; ++n) _Pragma("unroll") for (int k = 0; k < 2; ++k) dst[n][k] = *(const PG8_LAS bf16x8*)(lds + PG8_SB(b, h) + boff + n * 2048 + k * 1024); } while (0)
#define PG8_MMA(ai, bj, At, Bt) do { __builtin_amdgcn_s_setprio(1); _Pragma("unroll") for (int m = 0; m < 4; ++m) _Pragma("unroll") for (int n = 0; n < 2; ++n) _Pragma("unroll") for (int k = 0; k < 2; ++k) \
        acc[ai][bj][m][n] = __builtin_amdgcn_mfma_f32_16x16x32_bf16(Bt[n][k], At[m][k], acc[ai][bj][m][n], 0, 0, 0); __builtin_amdgcn_s_setprio(0); } while (0)
#define PG8_WAIT_V(n) asm volatile("s_waitcnt vmcnt(" #n ")" ::: "memory")
#define PG8_WAIT_L(n) asm volatile("s_waitcnt lgkmcnt(" #n ")" ::: "memory")
#define PG8_BAR __builtin_amdgcn_s_barrier()
#define PG8_SCHED __builtin_amdgcn_sched_barrier(0)
    Unit cur, nxt; int ui = 0;
    if (!S.next(0, cur)) return;
    f32x4 acc[2][2][4][2];
#pragma unroll
    for (int a = 0; a < 2; ++a)
#pragma unroll
        for (int b = 0; b < 2; ++b)
#pragma unroll
            for (int m = 0; m < 4; ++m)
#pragma unroll
                for (int n = 0; n < 2; ++n) acc[a][b][m][n] = (f32x4){0.f, 0.f, 0.f, 0.f};
    bf16x8 At[4][2], B0[2][2], B1[2][2];
    const char* cA = (const char*)g.A + (size_t)cur.pm * tstep; const char* cB = (const char*)g.Bt + (size_t)cur.pn * tstep;
    S.a_ready(cur);
    if constexpr (SP2) {
        PG8_STAGE(PG8_SB(0, 0), cB, voffB); PG8_STAGE(PG8_SB(0, 1), cB + hstep, voffB); PG8_STAGE(PG8_SA(0, 0), cA, voffA); PG8_STAGE(PG8_SA(0, 1), cA + hstep, voffA);
        if (wr == 1) PG8_BAR;
        PG8_WAIT_V(2); PG8_BAR;
        PG8_STAGE(PG8_SB(1, 0), cB + kstep, voffB); PG8_STAGE(PG8_SA(1, 0), cA + kstep, voffA); PG8_STAGE(PG8_SB(1, 1), cB + hstep + kstep, voffB);
        PG8_WAIT_V(6); PG8_BAR;
    } else {
        PG8_STAGE(PG8_SB(0, 0), cB, voffB); PG8_STAGE(PG8_SA(0, 0), cA, voffA); PG8_STAGE(PG8_SB(0, 1), cB + hstep, voffB); PG8_STAGE(PG8_SA(0, 1), cA + hstep, voffA);
        if (wr == 1) PG8_BAR;
        PG8_WAIT_V(4); PG8_BAR;
        PG8_STAGE(PG8_SB(1, 0), cB + kstep, voffB); PG8_STAGE(PG8_SA(1, 0), cA + kstep, voffA); PG8_STAGE(PG8_SB(1, 1), cB + hstep + kstep, voffB);
        PG8_WAIT_V(6); PG8_BAR;
    }
    for (;;) {
        const bool has_next = S.next(ui + 1, nxt);
        const char* nA = has_next ? (const char*)g.A + (size_t)nxt.pm * tstep : cA; const char* nB = has_next ? (const char*)g.Bt + (size_t)nxt.pn * tstep : cB;
        for (int t = 0; t < nt; t += 2) {
            const bool last = (t == nt - 2);
            const char* a1 = cA + (size_t)(t + 1) * kstep;
            const char* a2 = last ? nA : cA + (size_t)(t + 2) * kstep; const char* b2 = last ? nB : cB + (size_t)(t + 2) * kstep;
            const char* a3 = a2 + kstep; const char* b3 = b2 + kstep;
            if (last && has_next) S.a_ready(nxt);
            if constexpr (SP2) {
            PG8_LDB(B0, 0, 0); PG8_LDB(B1, 0, 1); PG8_SCHED; PG8_LDA(At, 0, 0); PG8_STAGE(PG8_SA(1, 1), a1 + hstep, voffA);
            PG8_WAIT_V(8); PG8_WAIT_L(0); PG8_BAR; PG8_MMA(0, 0, At, B0); PG8_MMA(0, 1, At, B1); PG8_BAR; PG8_SCHED;
            PG8_LDA(At, 0, 1); PG8_STAGE(PG8_SB(0, 0), b2, voffB); PG8_STAGE(PG8_SB(0, 1), b2 + hstep, voffB); PG8_STAGE(PG8_SA(0, 0), a2, voffA);
            PG8_WAIT_V(8); PG8_WAIT_L(0); PG8_BAR; PG8_MMA(1, 0, At, B0); PG8_MMA(1, 1, At, B1); PG8_BAR; PG8_SCHED;
            PG8_LDB(B0, 1, 0); PG8_LDB(B1, 1, 1); PG8_SCHED; PG8_LDA(At, 1, 0); PG8_STAGE(PG8_SA(0, 1), a2 + hstep, voffA);
            PG8_WAIT_V(8); PG8_WAIT_L(0); PG8_BAR; PG8_MMA(0, 0, At, B0); PG8_MMA(0, 1, At, B1); PG8_BAR; PG8_SCHED;
            PG8_LDA(At, 1, 1); PG8_STAGE(PG8_SB(1, 0), b3, voffB); PG8_STAGE(PG8_SB(1, 1), b3 + hstep, voffB); PG8_STAGE(PG8_SA(1, 0), a3, voffA);
            PG8_WAIT_V(8); PG8_WAIT_L(0); PG8_BAR; PG8_MMA(1, 0, At, B0); PG8_MMA(1, 1, At, B1); PG8_BAR; PG8_SCHED;
            } else {
            PG8_LDB(B0, 0, 0); PG8_SCHED; PG8_LDA(At, 0, 0); PG8_STAGE(PG8_SA(1, 1), a1 + hstep, voffA);
            PG8_WAIT_L(8); PG8_BAR; PG8_WAIT_L(0); PG8_MMA(0, 0, At, B0); PG8_BAR; PG8_SCHED;
            PG8_LDB(B1, 0, 1); PG8_STAGE(PG8_SB(0, 0), b2, voffB);
            PG8_BAR; PG8_WAIT_L(0); PG8_MMA(0, 1, At, B1); PG8_BAR;
            PG8_LDA(At, 0, 1); PG8_STAGE(PG8_SA(0, 0), a2, voffA);
            PG8_BAR; PG8_WAIT_L(0); PG8_MMA(1, 0, At, B0); PG8_BAR; PG8_SCHED;
            PG8_STAGE(PG8_SB(0, 1), b2 + hstep, voffB);
            PG8_WAIT_V(6); PG8_BAR; PG8_MMA(1, 1, At, B1); PG8_BAR;
            PG8_LDB(B0, 1, 0); PG8_SCHED; PG8_LDA(At, 1, 0); PG8_STAGE(PG8_SA(0, 1), a2 + hstep, voffA);
            PG8_WAIT_L(8); PG8_BAR; PG8_WAIT_L(0); PG8_MMA(0, 0, At, B0); PG8_BAR; PG8_SCHED;
            PG8_LDB(B1, 1, 1); PG8_STAGE(PG8_SB(1, 0), b3, voffB);
            PG8_BAR; PG8_WAIT_L(0); PG8_MMA(0, 1, At, B1); PG8_BAR;
            PG8_LDA(At, 1, 1); PG8_STAGE(PG8_SA(1, 0), a3, voffA);
            PG8_BAR; PG8_WAIT_L(0); PG8_MMA(1, 0, At, B0); PG8_BAR; PG8_SCHED;
            PG8_STAGE(PG8_SB(1, 1), b3 + hstep, voffB);
            PG8_WAIT_V(6); PG8_BAR; PG8_MMA(1, 1, At, B1); PG8_BAR;
            }
        }
        if constexpr (ALIGN_EPI) { if (wr == 0) PG8_BAR; }
        if constexpr (!Epi::AFTER_DRAIN) { E(acc, cur, wr, wc, fr, fq); S.done(cur); }
        if (!has_next) break;
#pragma unroll
        for (int a = 0; a < 2; ++a)
#pragma unroll
            for (int b = 0; b < 2; ++b)
#pragma unroll
                for (int m = 0; m < 4; ++m)
#pragma unroll
                    for (int n = 0; n < 2; ++n) acc[a][b][m][n] = (f32x4){0.f, 0.f, 0.f, 0.f};
        cur = nxt; cA = nA; cB = nB; ++ui;
        if constexpr (ALIGN_EPI) { if (wr == 1) PG8_BAR; }
    }
    PG8_WAIT_V(0);
    if constexpr (!ALIGN_EPI) { if (wr == 0) PG8_BAR; }
    PG8_BAR;
    if constexpr (Epi::AFTER_DRAIN) { E.fused(acc, cur, wr, wc, fr, fq, lds, wid, lane); S.done(cur); }
#undef PG8_SA
#undef PG8_SB
#undef PG8_STAGE
#undef PG8_LDA
#undef PG8_LDB
#undef PG8_MMA
#undef PG8_WAIT_V
#undef PG8_WAIT_L
#undef PG8_BAR
#undef PG8_SCHED
}
}

#ifndef PG8_SP2
#define PG8_SP2 true
#endif
#ifndef PG8_ALIGN
#define PG8_ALIGN true
#endif
#include <hip/hip_bf16.h>
#include <cmath>
namespace attn_body {
using bf16=__hip_bfloat16;
using bf16x8=__attribute__((ext_vector_type(8)))short;
using s16x4=__attribute__((ext_vector_type(4)))short;
using f32x16=__attribute__((ext_vector_type(16)))float;
using u32x4=__attribute__((ext_vector_type(4)))unsigned;
constexpr int D=64,QP=1024,KP=256;
constexpr int NW=8,QBLK=32,QB=QBLK*NW,KVBLK=64;
constexpr int ATTN_UNIT_ROWS=QB;
__device__ __forceinline__ int crow(int r,int hi){return (r&3)+8*(r>>2)+4*hi;}
#define SBAR() __builtin_amdgcn_sched_barrier(0)
constexpr int NSLOT=3, SLOTB=8192;
constexpr int LDS_K=0, LDS_V=NSLOT*SLOTB, LDS_WS=2*NSLOT*SLOTB, LDS_OST=LDS_WS+NW*64*4, LDS_BYTES=LDS_OST+NW*4096;
constexpr float C2=0.125f*1.4426950408889634f;
__device__ __forceinline__ void glds16(const void*gsrc,unsigned lds_dst){unsigned keep;
  asm volatile("s_mov_b32 %0, m0\n\ts_mov_b32 m0, %2\n\ts_nop 0\n\tglobal_load_lds_dwordx4 %1, off\n\ts_mov_b32 m0, %0":"=&s"(keep):"v"(gsrc),"s"(lds_dst):"memory");}
__device__ __forceinline__ float max3f(float a,float b,float c){float r;asm("v_max3_f32 %0, %1, %2, %3":"=v"(r):"v"(a),"v"(b),"v"(c));return r;}
__device__ __forceinline__ float max2f(float a,float b){float r;asm("v_max_f32_e32 %0, %1, %2":"=v"(r):"v"(a),"v"(b));return r;}
__device__ __forceinline__ float fadd_s(float a,float b){float r;asm("v_add_f32_e32 %0, %1, %2":"=v"(r):"v"(a),"v"(b));return r;}
__device__ __forceinline__ float fsub_s(float a,float b){float r;asm("v_sub_f32_e32 %0, %1, %2":"=v"(r):"v"(a),"v"(b));return r;}
typedef float f32x2_t __attribute__((ext_vector_type(2))); typedef __bf16 bf16x2_t __attribute__((ext_vector_type(2)));
__device__ __forceinline__ unsigned cvtpk_s(float lo,float hi){f32x2_t v={lo,hi};bf16x2_t b=__builtin_convertvector(v,bf16x2_t);return __builtin_bit_cast(unsigned,b);}
#define WAIT_BAR(N) asm volatile("s_waitcnt vmcnt(" #N ") lgkmcnt(0)\n\ts_barrier":::"memory")

__device__ __forceinline__ void qkt(f32x16&p0,f32x16&p1,const char*Kslot,const bf16x8*qr,const f32x16&negm,int r32,int hi){
  const char*kb=Kslot+hi*1024+r32*16;
  #pragma unroll
  for(int d0=0;d0<4;++d0){
    const bf16x8 b0=*reinterpret_cast<const bf16x8*>(kb+d0*2048);
    const bf16x8 b1=*reinterpret_cast<const bf16x8*>(kb+d0*2048+512);
    if(d0==0){p0=__builtin_amdgcn_mfma_f32_32x32x16_bf16(b0,qr[0],negm,0,0,0);p1=__builtin_amdgcn_mfma_f32_32x32x16_bf16(b1,qr[0],negm,0,0,0);}
    else{p0=__builtin_amdgcn_mfma_f32_32x32x16_bf16(b0,qr[d0],p0,0,0,0);p1=__builtin_amdgcn_mfma_f32_32x32x16_bf16(b1,qr[d0],p1,0,0,0);}}
}
typedef __attribute__((address_space(3))) const char* lds_cptr;
typedef short v4i16_t __attribute__((ext_vector_type(4)));
__device__ __forceinline__ void kload8(bf16x8*kf,lds_cptr kp){
  kf[0]=*(const __attribute__((address_space(3))) bf16x8*)(kp);      kf[1]=*(const __attribute__((address_space(3))) bf16x8*)(kp+512);
  kf[2]=*(const __attribute__((address_space(3))) bf16x8*)(kp+2048); kf[3]=*(const __attribute__((address_space(3))) bf16x8*)(kp+2560);
  kf[4]=*(const __attribute__((address_space(3))) bf16x8*)(kp+4096); kf[5]=*(const __attribute__((address_space(3))) bf16x8*)(kp+4608);
  kf[6]=*(const __attribute__((address_space(3))) bf16x8*)(kp+6144); kf[7]=*(const __attribute__((address_space(3))) bf16x8*)(kp+6656);
}
__device__ __forceinline__ void kload2(bf16x8*kf,lds_cptr kp,int j){ kf[2*j]=*(const __attribute__((address_space(3))) bf16x8*)(kp+j*2048); kf[2*j+1]=*(const __attribute__((address_space(3))) bf16x8*)(kp+j*2048+512); }
__device__ __forceinline__ s16x4 vtr(lds_cptr p){ return __builtin_bit_cast(s16x4,__builtin_amdgcn_ds_read_tr16_b64_v4i16((__attribute__((address_space(3))) v4i16_t*)p)); }
__device__ __forceinline__ float rowmax(const f32x16&p0,const f32x16&p1){
  float a=max3f(p0[0],p0[1],p1[0]),b=max3f(p0[2],p0[3],p1[1]);a=max3f(a,p1[2],p1[3]);
  #pragma unroll
  for(int r=4;r<16;r+=4){a=max3f(a,p0[r],p0[r+1]);b=max3f(b,p0[r+2],p0[r+3]);a=max3f(a,p1[r],p1[r+1]);b=max3f(b,p1[r+2],p1[r+3]);}
  const float m=max2f(a,b);
  auto rr=__builtin_amdgcn_permlane32_swap(__float_as_uint(m),__float_as_uint(m),false,false);
  return max2f(__uint_as_float(rr[0]),__uint_as_float(rr[1]));
}
__device__ __forceinline__ void pv(f32x16*o,int vb,bf16x8 pa0,bf16x8 pa1,bf16x8 pa2,bf16x8 pa3){
  #pragma unroll
  for(int d0=0;d0<2;++d0){s16x4 lo[4],hi[4];
    #pragma unroll
    for(int ks=0;ks<4;++ks){
      asm volatile("ds_read_b64_tr_b16 %0,%1 offset:%c2":"=&v"(lo[ks]):"v"(vb),"i"(d0*4096+ks*1024):"memory");
      asm volatile("ds_read_b64_tr_b16 %0,%1 offset:%c2":"=&v"(hi[ks]):"v"(vb),"i"(d0*4096+ks*1024+512):"memory");}
    asm volatile("s_waitcnt lgkmcnt(0)":::"memory");SBAR();
    #define PK(k) (bf16x8){lo[k][0],lo[k][1],lo[k][2],lo[k][3],hi[k][0],hi[k][1],hi[k][2],hi[k][3]}
    o[d0]=__builtin_amdgcn_mfma_f32_32x32x16_bf16(pa0,PK(0),o[d0],0,0,0);
    o[d0]=__builtin_amdgcn_mfma_f32_32x32x16_bf16(pa1,PK(1),o[d0],0,0,0);
    o[d0]=__builtin_amdgcn_mfma_f32_32x32x16_bf16(pa2,PK(2),o[d0],0,0,0);
    o[d0]=__builtin_amdgcn_mfma_f32_32x32x16_bf16(pa3,PK(3),o[d0],0,0,0);
    #undef PK
  }
}

#ifndef ATTN_STORE16
#define ATTN_STORE16(p,v) (*(u32x4*)(p)=(v))
#endif
template<int THRL,bool NOMAX> __device__ __forceinline__ void attn_unit(long rowbase,int NT,int h,int qb,const bf16*Q,const bf16*__restrict__ Kh,const bf16*__restrict__ Vh,bf16*O,char*shm,
    bool first,bool has_next,long n_rowbase,int n_h,int n_qb,const bf16*__restrict__ n_Kh,bf16x8 (&qr)[4]){
  const int tid=threadIdx.x,lane=tid&63,r32=lane&31,hi=lane>>5; const int wid=__builtin_amdgcn_readfirstlane(tid>>6);
  const int q0=qb*QB;
  const bf16*Qw=Q+(rowbase+q0+wid*QBLK)*QP+h*D;
  const unsigned lds0=(unsigned)(uintptr_t)shm;
  float*wsf=(float*)(shm+LDS_WS)+wid*64;
  const bf16*ksrc=Kh+(long)lane*KP+wid*8;
  const bf16*vsrc=Vh+(long)(16*(wid&3)+(lane>>2))*KP+(wid>>2)*32+(lane&3)*8;
  const unsigned kdst=lds0+LDS_K+wid*1024, vdst=lds0+LDS_V+wid*1024;
  #define DMA_K(t,slot) glds16(ksrc+(long)(t)*KVBLK*KP,(unsigned)__builtin_amdgcn_readfirstlane(kdst+(slot)))
  #define DMA_V(t,slot) glds16(vsrc+(long)(t)*KVBLK*KP,(unsigned)__builtin_amdgcn_readfirstlane(vdst+(slot)))
  const int vb0=(int)(lds0+LDS_V)+((lane>>4)&1)*32+(lane&3)*8+(4*hi+((lane&15)>>2))*64;
  const char*Kbase=shm+LDS_K; bf16x8 kf[8];
  const lds_cptr shm3=(lds_cptr)shm; const lds_cptr kp0=shm3+LDS_K+hi*1024+r32*16; const lds_cptr vp0=shm3+LDS_V+((lane>>4)&1)*32+(lane&3)*8+(4*hi+((lane&15)>>2))*64;
  if(first){ DMA_K(0,0);DMA_V(0,0);DMA_K(1,SLOTB);
  #pragma unroll
  for(int d0=0;d0<4;++d0)qr[d0]=*reinterpret_cast<const bf16x8*>(&Qw[(long)r32*QP+d0*16+hi*8]); }
  float mhat=0.f,l_reg=0.f;f32x16 o[2];o[0]=f32x16{};o[1]=f32x16{};f32x16 negm=f32x16{};asm volatile("":"+v"(negm));
  #define CMASK(P0,P1,t) do{}while(0)
  bool resc=false;
  #define START(P0,P1) do{ const float rm=rowmax(P0,P1); resc=false; \
    { const float dl=rm; mhat=fadd_s(mhat,dl); \
      _Pragma("unroll") for(int r=0;r<16;++r){P0[r]=fsub_s(P0[r],dl);P1[r]=fsub_s(P1[r],dl);} \
      _Pragma("unroll") for(int r=0;r<16;++r)negm[r]=-mhat; asm volatile("":"+v"(negm)); } \
    _Pragma("unroll") for(int r=0;r<16;++r)P0[r]=__builtin_amdgcn_exp2f(P0[r]); }while(0)
  #define RESC() do{ if(resc){ asm volatile("s_waitcnt lgkmcnt(0)":::"memory"); \
      _Pragma("unroll") for(int d_=0;d_<2;++d_) _Pragma("unroll") for(int r=0;r<16;++r)o[d_][r]*=wsf[crow(r,hi)]; } }while(0)
  f32x16 pA0,pA1,pB0,pB1;
  int sl_prev=0,sl_cur=0,sl_next=SLOTB;
  #define ROT() do{sl_prev=sl_cur;sl_cur=sl_next;sl_next=(sl_next==(NSLOT-1)*SLOTB)?0:sl_next+SLOTB;}while(0)
  if(first){ DMA_K(2,2*SLOTB);
  WAIT_BAR(3); }
  else { DMA_V(0,0); WAIT_BAR(1); }
  qkt(pA0,pA1,Kbase,qr,negm,r32,hi);asm volatile("s_nop 15\n\ts_nop 7":"+v"(pA0),"+v"(pA1));CMASK(pA0,pA1,0);
  START(pA0,pA1);
  _Pragma("unroll") for(int r=0;r<16;++r)pA1[r]=__builtin_amdgcn_exp2f(pA1[r]);
  WAIT_BAR(0);
  DMA_K(3,0);DMA_V(1,SLOTB);
  ROT();
  kload8(kf,kp0+sl_cur);
  WAIT_BAR(2);
  s16x4 vlo[8],vhi[8]; u32x4 pw0,pw1,pw2,pw3;
  #define PKW(P,B) cvtpk_s(P[B],P[B+1])
  #define PAF(k) __builtin_bit_cast(bf16x8,pw##k)
  #define VFR(i) (bf16x8){vlo[i][0],vlo[i][1],vlo[i][2],vlo[i][3],vhi[i][0],vhi[i][1],vhi[i][2],vhi[i][3]}
  #define PIN(x) asm volatile("":"+v"(x))
  #define MX3(a,b,c) __builtin_fmaxf(__builtin_fmaxf((a),(b)),(c))
  #define GAPA(MF,A0,A1,A2,A3,W0,W1,PW) do{ MF; sacc+=A0; sacc+=A1; sacc+=A2; sacc+=A3; PIN(sacc); W0; W1; PIN(PW); SBAR(); }while(0)
  #define EX(v) __builtin_amdgcn_exp2f(v)
  #define GAPB(MF,X,B) do{ MF; X[B]=EX(X[B]); X[B+1]=EX(X[B+1]); X[B+2]=EX(X[B+2]); X[B+3]=EX(X[B+3]); PIN(X); SBAR(); }while(0)
  #define VRD(i) do{ vlo[i]=vtr(vp_+(((i)>>2)*4096+((i)&3)*1024)); vhi[i]=vtr(vp_+(((i)>>2)*4096+((i)&3)*1024+512)); }while(0)
  #define KRD(G,j) do{ if(G){ kload2(kf,kp0+sl_next,j); SBAR(); } }while(0)
  #define STEP(C0,C1,P0,P1,t,GK,GV,GL) do{ SBAR(); \
    const lds_cptr vp_=vp0+sl_prev; \
    VRD(0); SBAR(); float sacc=(P0[0]+P0[1]); \
    GAPA(C0=__builtin_amdgcn_mfma_f32_32x32x16_bf16(kf[0],qr[0],negm,0,0,0), P0[2],P0[3],P0[4],P0[5],     pw0[0]=PKW(P0,0), pw0[1]=PKW(P0,2), pw0); \
    VRD(4); SBAR(); GAPA(C1=__builtin_amdgcn_mfma_f32_32x32x16_bf16(kf[1],qr[0],negm,0,0,0), P0[6],P0[7],P0[8],P0[9],     pw0[2]=PKW(P0,4), pw0[3]=PKW(P0,6), pw0); \
    VRD(1); SBAR(); GAPA(C0=__builtin_amdgcn_mfma_f32_32x32x16_bf16(kf[2],qr[1],C0,0,0,0),   P0[10],P0[11],P0[12],P0[13], pw1[0]=PKW(P0,8), pw1[1]=PKW(P0,10), pw1); \
    VRD(5); SBAR(); GAPA(C1=__builtin_amdgcn_mfma_f32_32x32x16_bf16(kf[3],qr[1],C1,0,0,0),   P0[14],P0[15],P1[0],P1[1],   pw1[2]=PKW(P0,12),pw1[3]=PKW(P0,14), pw1); \
    VRD(2); SBAR(); GAPA(C0=__builtin_amdgcn_mfma_f32_32x32x16_bf16(kf[4],qr[2],C0,0,0,0),   P1[2],P1[3],P1[4],P1[5],     pw2[0]=PKW(P1,0), pw2[1]=PKW(P1,2), pw2); \
    VRD(6); SBAR(); GAPA(C1=__builtin_amdgcn_mfma_f32_32x32x16_bf16(kf[5],qr[2],C1,0,0,0),   P1[6],P1[7],P1[8],P1[9],     pw2[2]=PKW(P1,4), pw2[3]=PKW(P1,6), pw2); \
    VRD(3); SBAR(); GAPA(C0=__builtin_amdgcn_mfma_f32_32x32x16_bf16(kf[6],qr[3],C0,0,0,0),   P1[10],P1[11],P1[12],P1[13], pw3[0]=PKW(P1,8), pw3[1]=PKW(P1,10), pw3); \
    VRD(7); SBAR(); GAPA(C1=__builtin_amdgcn_mfma_f32_32x32x16_bf16(kf[7],qr[3],C1,0,0,0),   P1[14],P1[15],0.f,0.f,       pw3[2]=PKW(P1,12),pw3[3]=PKW(P1,14), pw3); \
    l_reg+=sacc; \
    if(GK){DMA_K((t)+3,sl_cur);} if(GV){DMA_V((t)+1,sl_next);} \
    CMASK(C0,C1,t); \
    if constexpr(NOMAX){ resc=false; } else { float a=MX3(C0[0],C0[1],C1[0]),b=MX3(C0[2],C0[3],C1[1]); a=MX3(a,C1[2],C1[3]); \
      _Pragma("unroll") for(int r=4;r<16;r+=4){a=MX3(a,C0[r],C0[r+1]);b=MX3(b,C0[r+2],C0[r+3]);a=MX3(a,C1[r],C1[r+1]);b=MX3(b,C1[r+2],C1[r+3]);} \
      float rm=__builtin_fmaxf(a,b); { auto rr=__builtin_amdgcn_permlane32_swap(__float_as_uint(rm),__float_as_uint(rm),false,false); rm=__builtin_fmaxf(__uint_as_float(rr[0]),__uint_as_float(rr[1])); } \
      resc=false; \
      if(__builtin_expect(__any(rm>(float)THRL),0)){ const float dl=__builtin_fmaxf(rm,0.f); mhat+=dl; \
        _Pragma("unroll") for(int r=0;r<16;++r){C0[r]-=dl;C1[r]-=dl;} \
        _Pragma("unroll") for(int r=0;r<16;++r)negm[r]=-mhat; asm volatile("":"+v"(negm)); \
        const float f=__builtin_amdgcn_exp2f(-dl); l_reg*=f; if(hi==0)wsf[r32]=f; resc=true; } } \
    SBAR(); \
    GAPB(o[0]=__builtin_amdgcn_mfma_f32_32x32x16_bf16(PAF(0),VFR(0),o[0],0,0,0), C0,0); \
    GAPB(o[1]=__builtin_amdgcn_mfma_f32_32x32x16_bf16(PAF(0),VFR(4),o[1],0,0,0), C0,4); \
    KRD(GL,0); GAPB(o[0]=__builtin_amdgcn_mfma_f32_32x32x16_bf16(PAF(1),VFR(1),o[0],0,0,0), C0,8); \
    KRD(GL,1); GAPB(o[1]=__builtin_amdgcn_mfma_f32_32x32x16_bf16(PAF(1),VFR(5),o[1],0,0,0), C0,12); \
    KRD(GL,2); GAPB(o[0]=__builtin_amdgcn_mfma_f32_32x32x16_bf16(PAF(2),VFR(2),o[0],0,0,0), C1,0); \
    KRD(GL,3); GAPB(o[1]=__builtin_amdgcn_mfma_f32_32x32x16_bf16(PAF(2),VFR(6),o[1],0,0,0), C1,4); \
    GAPB(o[0]=__builtin_amdgcn_mfma_f32_32x32x16_bf16(PAF(3),VFR(3),o[0],0,0,0), C1,8); \
    GAPB(o[1]=__builtin_amdgcn_mfma_f32_32x32x16_bf16(PAF(3),VFR(7),o[1],0,0,0), C1,12); \
    }while(0)
  int t=1;
  #undef CMASK
  #define CMASK(P0,P1,t) do{}while(0)
  for(;t+5<NT;t+=2){
    STEP(pB0,pB1,pA0,pA1,t,true,true,true);     WAIT_BAR(2); RESC(); ROT();
    STEP(pA0,pA1,pB0,pB1,t+1,true,true,true);   WAIT_BAR(2); RESC(); ROT();
  }
  #undef CMASK
  #define CMASK(P0,P1,t) do{}while(0)
  #define ENDW(tt) do{ if((tt)+3<NT){WAIT_BAR(2);} else if((tt)+2<NT){WAIT_BAR(1);} else {WAIT_BAR(0);} }while(0)
  for(;t+1<NT;t+=2){
    STEP(pB0,pB1,pA0,pA1,t,(t+3<NT),(t+1<NT),(t+1<NT));       ENDW(t);   RESC(); ROT();
    STEP(pA0,pA1,pB0,pB1,t+1,(t+4<NT),(t+2<NT),(t+2<NT));     ENDW(t+1); RESC(); ROT();
  }
  if(has_next){ const bf16*ksn=n_Kh+(long)lane*KP+wid*8;
    glds16(ksn,(unsigned)__builtin_amdgcn_readfirstlane(kdst)); glds16(ksn+(long)KVBLK*KP,(unsigned)__builtin_amdgcn_readfirstlane(kdst+SLOTB)); glds16(ksn+(long)2*KVBLK*KP,(unsigned)__builtin_amdgcn_readfirstlane(kdst+2*SLOTB)); }
  STEP(pB0,pB1,pA0,pA1,NT-1,false,false,false);
  if(has_next){ const bf16*Qn=Q+(n_rowbase+n_qb*QB+wid*QBLK)*QP+n_h*D;
    _Pragma("unroll") for(int d0=0;d0<4;++d0)qr[d0]=*reinterpret_cast<const bf16x8*>(&Qn[(long)r32*QP+d0*16+hi*8]); }
  RESC();
  { float sacc=pB0[0]+pB0[1]; _Pragma("unroll") for(int r=2;r<16;++r)sacc+=pB0[r]; _Pragma("unroll") for(int r=0;r<16;++r)sacc+=pB1[r]; l_reg+=sacc;
    pw0=(u32x4){PKW(pB0,0),PKW(pB0,2),PKW(pB0,4),PKW(pB0,6)};pw1=(u32x4){PKW(pB0,8),PKW(pB0,10),PKW(pB0,12),PKW(pB0,14)};pw2=(u32x4){PKW(pB1,0),PKW(pB1,2),PKW(pB1,4),PKW(pB1,6)};pw3=(u32x4){PKW(pB1,8),PKW(pB1,10),PKW(pB1,12),PKW(pB1,14)};
    SBAR(); pv(o,vb0+sl_cur,PAF(0),PAF(1),PAF(2),PAF(3)); }
  #undef PKW
  #undef PAF
  #undef VFR
  #undef PIN
  #undef MX3
  #undef GAPA
  #undef GAPB
  #undef EX
  #undef VRD
  #undef KRD
  #undef STEP
  #undef ENDW
  {auto rr=__builtin_amdgcn_permlane32_swap(__float_as_uint(l_reg),__float_as_uint(l_reg),false,false);l_reg=__uint_as_float(rr[0])+__uint_as_float(rr[1]);}
  if(hi==0)wsf[32+r32]=l_reg;asm volatile("s_waitcnt lgkmcnt(0)":::"memory");
  float rli[16];
  #pragma unroll
  for(int r=0;r<16;++r)rli[r]=__builtin_amdgcn_rcpf(wsf[32+crow(r,hi)]);
  bf16*Ow=O+(rowbase+q0+wid*QBLK)*QP+h*D;
  { bf16*stg=(bf16*)(shm+LDS_OST)+wid*2048;
    #pragma unroll
    for(int r=0;r<16;++r){const int orow=crow(r,hi);
      #pragma unroll
      for(int d0=0;d0<2;++d0)stg[orow*64+d0*32+r32]=__float2bfloat16(o[d0][r]*rli[r]);}
    asm volatile("s_waitcnt lgkmcnt(0)":::"memory");
    #pragma unroll
    for(int i=0;i<4;++i){const int row=i*8+(lane>>3),ch=lane&7; const u32x4 v=*(const u32x4*)(stg+row*64+ch*8); ATTN_STORE16(Ow+(long)row*QP+ch*8,v);} }
  asm volatile("s_waitcnt lgkmcnt(0)\n\ts_barrier":::"memory");
  #undef DMA_K
  #undef DMA_V
  #undef CMASK
  #undef START
  #undef RESC
  #undef ROT
}
constexpr int ATTN_LDS_BYTES=LDS_BYTES;
#undef SBAR
#undef WAIT_BAR
}
constexpr int NWAVES = 8;
#ifndef MK_N_LAUNCHES
#define MK_N_LAUNCHES 1
#endif
#ifndef PROBE_PH
#define PROBE_PH -1
#endif
constexpr int N_LAUNCHES = MK_N_LAUNCHES;
constexpr int PER_PHASE = 6;

constexpr int D = 1024, FF = 4096, NIN = 1280, HD = 64;
constexpr int M = 49152;
constexpr int ROWS_P = 32768;
constexpr float EPS = 1e-6f;

constexpr size_t MiB = 1u << 20;
constexpr size_t WS_CTL = 0, CTL_ZERO_BYTES = 16384;
constexpr size_t WS_ROPE = 1 * MiB;
constexpr size_t WS_XINV = WS_ROPE + 65536;
constexpr size_t WS_STATS = 2 * MiB;
constexpr size_t WS_WIN = 6 * MiB, WS_WO = 9 * MiB, WS_WUP = 11 * MiB, WS_WDN = 19 * MiB;
constexpr size_t WS_XN = 32 * MiB;
constexpr size_t WS_MIX = 128 * MiB;
constexpr size_t WS_KV = 224 * MiB;
constexpr size_t WS_U = 248 * MiB;
constexpr size_t WS_H = 128 * MiB;
constexpr size_t WS_END = 512 * MiB;
static_assert(WS_WDN + (size_t)D * FF * 2 <= WS_XN && WS_XN + (size_t)M * D * 2 <= WS_MIX && WS_U + (size_t)M * 512 * 2 <= WS_END && WS_H + (size_t)M * FF * 2 <= WS_END && WS_STATS + (size_t)M * 64 <= WS_WIN, "d_ws map");

constexpr int RING_OFF = 0, RING_BYTES = 131072;
constexpr int LDSCTL_OFF = RING_BYTES, MISC_OFF = LDSCTL_OFF + 320;
constexpr int UPTAB_OFF = RING_BYTES + 2048;
constexpr int LDS_BYTES = 147456;
static_assert(UPTAB_OFF + 12 * 256 * 4 <= LDS_BYTES, "LDS map");

#define GAS __attribute__((address_space(1)))
#define LAS __attribute__((address_space(3)))
typedef unsigned short bf16;
typedef unsigned v4u __attribute__((ext_vector_type(4)));
typedef float f32x4 __attribute__((ext_vector_type(4)));
#define LDS_WAIT() asm volatile("s_waitcnt lgkmcnt(0)" ::: "memory")
__device__ __forceinline__ unsigned f2bf(float f) { unsigned u = __builtin_bit_cast(unsigned, f); return (u + 0x7fffu + ((u >> 16) & 1u)) >> 16; }
typedef float f32x2_pk __attribute__((ext_vector_type(2))); typedef __bf16 bf16x2_pk __attribute__((ext_vector_type(2)));
__device__ __forceinline__ unsigned pk2(float lo, float hi) { const f32x2_pk v = {lo, hi}; return __builtin_bit_cast(unsigned, __builtin_convertvector(v, bf16x2_pk)); }
__device__ __forceinline__ float bflo(unsigned w) { return __builtin_bit_cast(float, w << 16); }
__device__ __forceinline__ float bfhi(unsigned w) { return __builtin_bit_cast(float, w & 0xffff0000u); }

#define XB_TMO      128
#define XB_XCNT(j)  (256  + 64 * (j))
#define XB_XSUB(j)  (1280 + 64 * (j))
#define XB_XGEN(j)  (2304 + 64 * (j))
#define XB_TOP      3328
#define XB_TOPGEN   3392
#define XCD_BAR_WORDS 3456
#define XB_SPIN_CAP (1u << 18)

__device__ __forceinline__ unsigned xb_ld(unsigned* p)              { return __hip_atomic_load(p, __ATOMIC_RELAXED, __HIP_MEMORY_SCOPE_AGENT); }
__device__ __forceinline__ unsigned xb_add(unsigned* p, unsigned v) { return __hip_atomic_fetch_add(p, v, __ATOMIC_RELAXED, __HIP_MEMORY_SCOPE_AGENT); }
__device__ __forceinline__ unsigned xb_xcc_id() { return (unsigned)__builtin_amdgcn_s_getreg((3 << 11) | 20) & 0xFu; }
#define XB_SPIN(cond, bar) do { unsigned _sp = 0; while (cond) { __builtin_amdgcn_s_sleep(1); \
    if ((++_sp & 255u) == 0u) { if (xb_ld(&(bar)[XB_TMO])) break; if (_sp > XB_SPIN_CAP) { atomicAdd(&(bar)[XB_TMO], 1u); break; } } } } while (0)

struct XcdBarrier {
    unsigned* bar; unsigned x;
    volatile LAS unsigned* st;
};

__device__ __forceinline__ XcdBarrier xcd_barrier_post(unsigned* bar, volatile LAS unsigned* st) {
    XcdBarrier b; b.bar = bar; b.x = xb_xcc_id(); b.st = st;
    if (threadIdx.x == 0) (void)xb_add(&bar[XB_XCNT(b.x)], 1u);
    return b;
}
__device__ __forceinline__ void xcd_barrier_complete(unsigned* bar, unsigned x, unsigned& nloc, unsigned& nx) {
    const unsigned G = gridDim.x * gridDim.y * gridDim.z;
    unsigned sum, cnt, mine, sp = 0u;
    for (;;) {
        sum = 0u; cnt = 0u; mine = 0u;
#pragma unroll
        for (unsigned j = 0; j < 16; ++j) { const unsigned c = xb_ld(&bar[XB_XCNT(j)]); sum += c; cnt += (c > 0u) ? 1u : 0u; mine = (j == x) ? c : mine; }
        if (sum == G) break;
        __builtin_amdgcn_s_sleep(1);
        if ((++sp & 255u) == 0u) { if (xb_ld(&bar[XB_TMO])) break; if (sp > XB_SPIN_CAP) { atomicAdd(&bar[XB_TMO], 1u); break; } }
    }
    nloc = mine > 0u ? mine : 1u; nx = cnt > 0u ? cnt : 1u;
}

__device__ __forceinline__ void xcd_barrier(const XcdBarrier& b) {
    asm volatile("s_waitcnt vmcnt(0)" ::: "memory");
    __syncthreads();
    if (threadIdx.x == 0) {
        unsigned* bar = b.bar;
        __builtin_amdgcn_s_waitcnt(0);
        unsigned nloc = b.st[0], nx = b.st[1];
        if (nloc == 0u) { xcd_barrier_complete(bar, b.x, nloc, nx); b.st[0] = nloc; b.st[1] = nx; }
        const unsigned old = xb_add(&bar[XB_XSUB(b.x)], 1u);
        const unsigned gen = old / nloc;
        if (old + 1u == (gen + 1u) * nloc) {
            __builtin_amdgcn_fence(__ATOMIC_RELEASE, "agent");
            asm volatile("s_waitcnt vmcnt(0)" ::: "memory");
            const unsigned og = xb_add(&bar[XB_TOP], 1u);
            const unsigned tg = og / nx;
            if (og + 1u == (tg + 1u) * nx) xb_add(&bar[XB_TOPGEN], 1u);
            else XB_SPIN(xb_ld(&bar[XB_TOPGEN]) == tg, bar);
            __builtin_amdgcn_fence(__ATOMIC_ACQUIRE, "agent");
            xb_add(&bar[XB_XGEN(b.x)], 1u);
            asm volatile("s_waitcnt vmcnt(0)" ::: "memory");
        } else {
            XB_SPIN(xb_ld(&bar[XB_XGEN(b.x)]) == gen, bar);
            __builtin_amdgcn_fence(__ATOMIC_ACQUIRE, "agent");
            asm volatile("s_waitcnt vmcnt(0)" ::: "memory");
        }
    }
    __syncthreads();
}

struct Frame {
    LAS unsigned char* lds;
    int tid, lane, wave, vcu, G;
    const float *xp, *xs, *g1, *win, *qg, *kg, *wpool, *pscale, *wout, *g2, *wup, *wdn;
    float* out;
    bf16 *Win_t, *Wo_t, *Wup_t, *Wdn_t, *XN, *MIX, *KV, *U, *H;
    float *cosT, *sinT, *stats, *xinv;
};

__device__ __forceinline__ float wave_sum(float v) {
#pragma unroll
    for (int o = 1; o < 64; o <<= 1) v += __shfl_xor(v, o);
    return v;
}
__device__ __forceinline__ int inproj_dst_row(int A) {
    const int pn = A >> 8, a = A & 255;
    if (pn >= 3) return A;
    const int bj = (a >> 5) & 1, i = a & 31, head = a >> 6;
    int c;
    if (pn == 2 && a >= 128) c = 128 * bj + 32 * head + i;
    else c = 128 * bj + 32 * head + 8 * ((i >> 2) & 3) + 4 * (i >> 4) + (i & 3);
    return 256 * pn + c;
}
template <int MODE> __device__ __forceinline__ void p0_transpose_item(const float* W, int N, bf16* WT, int ldt, const float* kscale, LAS float* scr, int item, int lane) {
    const int nblk = N / 32, kb = item / nblk, nb = item % nblk, k0 = 64 * kb, n0 = 32 * nb;
#pragma unroll
    for (int i = 0; i < 32; ++i) { const int kk = 2 * i + (lane >> 5); float v = W[(size_t)(k0 + kk) * N + n0 + (lane & 31)]; if (kscale) v *= kscale[k0 + kk]; scr[kk * 33 + (lane & 31)] = v; }
    LDS_WAIT(); asm volatile("" ::: "memory");
    const int c = lane & 7;
#pragma unroll
    for (int j = 0; j < 4; ++j) { const int n = (lane >> 3) + 8 * j; const LAS float* s = scr + (8 * c) * 33 + n;
        v4u o; o.x = pk2(s[0 * 33], s[1 * 33]); o.y = pk2(s[2 * 33], s[3 * 33]); o.z = pk2(s[4 * 33], s[5 * 33]); o.w = pk2(s[6 * 33], s[7 * 33]);
        const int dr = MODE == 1 ? inproj_dst_row(n0 + n) : (n0 + n);
        *(GAS v4u*)(WT + (size_t)dr * ldt + k0 + 8 * c) = o; }
    LDS_WAIT(); asm volatile("" ::: "memory");
}
__device__ __forceinline__ void titem_load(const float* tW, int tN, int tr, int lane, float (&v)[32]) {
    const int nblk = tN / 32, kb = tr / nblk, nb = tr % nblk, k0 = 64 * kb, n0 = 32 * nb;
#pragma unroll
    for (int i = 0; i < 32; ++i) { const int kk = 2 * i + (lane >> 5); v[i] = __builtin_nontemporal_load(tW + (size_t)(k0 + kk) * tN + n0 + (lane & 31)); }
}
__device__ __forceinline__ void titem_store(int tN, bf16* tWT, int tldt, const float* tks, int tmode, int tr, LAS float* scr, int lane, const float (&v)[32]) {
    const int nblk = tN / 32, kb = tr / nblk, nb = tr % nblk, k0 = 64 * kb, n0 = 32 * nb;
#pragma unroll
    for (int i = 0; i < 32; ++i) { const int kk = 2 * i + (lane >> 5); float x = v[i]; if (tks) x *= tks[k0 + kk]; scr[kk * 33 + (lane & 31)] = x; }
    LDS_WAIT(); asm volatile("" ::: "memory");
    const int c = lane & 7;
#pragma unroll
    for (int j = 0; j < 4; ++j) { const int n = (lane >> 3) + 8 * j; const LAS float* sp = scr + (8 * c) * 33 + n;
        v4u o; o.x = pk2(sp[0 * 33], sp[1 * 33]); o.y = pk2(sp[2 * 33], sp[3 * 33]); o.z = pk2(sp[4 * 33], sp[5 * 33]); o.w = pk2(sp[6 * 33], sp[7 * 33]);
        const int dr = tmode == 1 ? inproj_dst_row(n0 + n) : (n0 + n);
        *(GAS v4u*)(tWT + (size_t)dr * tldt + k0 + 8 * c) = o; }
    LDS_WAIT(); asm volatile("" ::: "memory");
}
__device__ __forceinline__ void rms_row_to_bf16(Frame& F, const f32x4 (&v)[4], bf16* orow, float* xinv_row) {
    const GAS f32x4* gr = (const GAS f32x4*)F.g1 + 2 * F.lane;
    float s = 0.f;
#pragma unroll
    for (int j = 0; j < 4; ++j) { s += (v[j].x * v[j].x + v[j].y * v[j].y) + (v[j].z * v[j].z + v[j].w * v[j].w); }
    const float ms = wave_sum(s) * (1.f / D) + EPS, rstd = __builtin_amdgcn_rsqf(ms), rms = ms * rstd;
    if (F.lane == 0) *xinv_row = rms;
    GAS v4u* o16 = (GAS v4u*)orow + F.lane;
#pragma unroll
    for (int j = 0; j < 2; ++j) { const f32x4 ga = gr[128 * j], gb = gr[128 * j + 1]; const f32x4 ya = v[2 * j] * rstd * ga, yb = v[2 * j + 1] * rstd * gb;
        v4u o; o.x = pk2(ya.x, ya.y); o.y = pk2(ya.z, ya.w); o.z = pk2(yb.x, yb.y); o.w = pk2(yb.z, yb.w); o16[64 * j] = o; }
}
constexpr int P0_WW = 2;
__device__ __forceinline__ void p0_prologue(Frame& F) {
    LAS float* scr = (LAS float*)(F.lds + RING_OFF + F.wave * 16384);
    if (F.wave < P0_WW) {
    const int gw = F.vcu * P0_WW + F.wave, NGW = F.G * P0_WW;
    const int gt = gw * 64 + F.lane, NGT = NGW * 64;
    for (int it = gt; it < 2048; it += NGT) {
        const int pos = it >> 4, f = it & 15; double invf = 1.0;
        for (int i = 0; i < f; ++i) invf *= 0.5623413251903491;
        const double a = (double)pos * invf, k = __builtin_rint(a * 0.15915494309189535), r = a - k * 6.283185307179586, r2 = r * r;
        double s = 1.0, c = 1.0;
        for (int i = 16; i >= 1; --i) { s = 1.0 - s * r2 / (double)((2 * i) * (2 * i + 1)); c = 1.0 - c * r2 / (double)((2 * i - 1) * (2 * i)); }
        s *= r; F.cosT[it] = (float)c; F.sinT[it] = (float)s;
    }
    for (int it = gt; it < 128 * 1024; it += NGT) {
        const int jb = __builtin_amdgcn_readfirstlane(it >> 10), n = it & 1023, g = jb >> 5, jj0 = (jb & 31) * 4;
        const float* wp = F.wpool + ((size_t)g * 128 + jj0) * 128; const float* ps = F.pscale + g * 128; const float* wo = F.wout + (size_t)(512 + g * 128) * 1024 + n;
        float a0 = 0.f, a1 = 0.f, a2 = 0.f, a3 = 0.f;
        for (int e0 = 0; e0 < 128; e0 += 32) { float w[32];
#pragma unroll
            for (int i = 0; i < 32; ++i) w[i] = wo[(size_t)(e0 + i) * 1024];
#pragma unroll
            for (int i = 0; i < 32; ++i) { const float ww = w[i] * ps[e0 + i]; a0 += wp[0 * 128 + e0 + i] * ww; a1 += wp[1 * 128 + e0 + i] * ww; a2 += wp[2 * 128 + e0 + i] * ww; a3 += wp[3 * 128 + e0 + i] * ww; } }
        typedef unsigned v2u __attribute__((ext_vector_type(2)));
        v2u o; o.x = pk2(a0, a1); o.y = pk2(a2, a3);
        *(GAS v2u*)(F.Wo_t + (size_t)n * 1024 + 512 + jb * 4) = o;
    }
    constexpr int I_IN = (D / 64) * (NIN / 32), I_O = (512 / 64) * (D / 32), I_UP = (D / 64) * (FF / 32), I_DN = (FF / 64) * (D / 32);
    constexpr int NITEMS = I_IN + I_O + I_UP + I_DN;
#define P0_DECODE(p, it_) const float* p##W; int p##N; bf16* p##WT; int p##ldt; const float* p##ks; int p##mode; int p##r; { int r_ = (it_); \
        if (r_ < I_IN) { p##W = F.win; p##N = NIN; p##WT = F.Win_t; p##ldt = D; p##ks = nullptr; p##mode = 1; p##r = r_; } \
        else if (r_ < I_IN + I_O) { p##W = F.wout; p##N = D; p##WT = F.Wo_t; p##ldt = D; p##ks = nullptr; p##mode = 0; p##r = r_ - I_IN; } \
        else if (r_ < I_IN + I_O + I_UP) { p##W = F.wup; p##N = FF; p##WT = F.Wup_t; p##ldt = D; p##ks = F.g2; p##mode = 0; p##r = r_ - I_IN - I_O; } \
        else { p##W = F.wdn; p##N = D; p##WT = F.Wdn_t; p##ldt = FF; p##ks = nullptr; p##mode = 0; p##r = r_ - I_IN - I_O - I_UP; } }
    for (int it = gw; it < NITEMS; it += 2 * NGW) {
        const int it2 = it + NGW; const bool two = it2 < NITEMS;
        P0_DECODE(ta, it) P0_DECODE(tb, two ? it2 : it)
        float va[32], vb[32];
        titem_load(taW, taN, tar, F.lane, va); titem_load(tbW, tbN, tbr, F.lane, vb);
        titem_store(taN, taWT, taldt, taks, tamode, tar, scr, F.lane, va); if (two) titem_store(tbN, tbWT, tbldt, tbks, tbmode, tbr, scr, F.lane, vb);
    }
#undef P0_DECODE
    } else {
    const int gw = F.vcu * (NWAVES - P0_WW) + (F.wave - P0_WW), NGW = F.G * (NWAVES - P0_WW);
    for (int m = gw; m < M; m += 4 * NGW) {
        f32x4 v[4][4];
#pragma unroll
        for (int q = 0; q < 4; ++q) { const int mm = m + q * NGW; if (mm < M) { const float* xrow = mm < ROWS_P ? F.xp + (size_t)mm * D : F.xs + (size_t)(mm - ROWS_P) * D; const GAS f32x4* xr = (const GAS f32x4*)xrow + 2 * F.lane;
#pragma unroll
            for (int j = 0; j < 2; ++j) { v[q][2 * j] = __builtin_nontemporal_load(xr + 128 * j); v[q][2 * j + 1] = __builtin_nontemporal_load(xr + 128 * j + 1); } } else {
#pragma unroll
            for (int j = 0; j < 4; ++j) v[q][j] = (f32x4){0.f, 0.f, 0.f, 0.f}; } }
#pragma unroll
        for (int q = 0; q < 4; ++q) { const int mm = m + q * NGW; if (mm < M) rms_row_to_bf16(F, v[q], F.XN + (size_t)mm * D, F.xinv + mm); }
    }
    }
}

template <int HW> struct PoolItem {
    v4u w[8 + 2 * HW]; int S, t0, seq0, cc;
    __device__ __forceinline__ void load(Frame& F, int g, int rg, int lane) {
        const int row0 = rg * 32 + (lane >> 4) * 8; cc = g * 16 + (lane & 15);
        if (row0 < ROWS_P) { S = 4096; t0 = row0 & 4095; } else { S = 8192; t0 = (row0 - ROWS_P) & 8191; }
        seq0 = row0 - t0;
        const GAS v4u* ub = (const GAS v4u*)(F.U + (size_t)seq0 * 512 + cc * 8);
#pragma unroll
        for (int k = 0; k < 8 + 2 * HW; ++k) { const int j = t0 - HW + k; w[k] = (j >= 0 && j < S) ? ub[(size_t)j * 64] : (v4u){0u, 0u, 0u, 0u}; }
    }
    __device__ __forceinline__ void finish(Frame& F) {
        float s0 = 0.f, s1 = 0.f, s2 = 0.f, s3 = 0.f, s4 = 0.f, s5 = 0.f, s6 = 0.f, s7 = 0.f;
#pragma unroll
        for (int k = 0; k < 2 * HW; ++k) { s0 += bflo(w[k].x); s1 += bfhi(w[k].x); s2 += bflo(w[k].y); s3 += bfhi(w[k].y); s4 += bflo(w[k].z); s5 += bfhi(w[k].z); s6 += bflo(w[k].w); s7 += bfhi(w[k].w); }
#pragma unroll
        for (int r = 0; r < 8; ++r) {
            const int t = t0 + r, lo = t - HW < 0 ? 0 : t - HW, hi = t + HW > S ? S : t + HW; const float inv = __builtin_amdgcn_rcpf((float)(hi - lo));
            const v4u c = w[r + HW];
            v4u o; o.x = pk2(s0 * inv - bflo(c.x), s1 * inv - bfhi(c.x)); o.y = pk2(s2 * inv - bflo(c.y), s3 * inv - bfhi(c.y)); o.z = pk2(s4 * inv - bflo(c.z), s5 * inv - bfhi(c.z)); o.w = pk2(s6 * inv - bflo(c.w), s7 * inv - bfhi(c.w));
            *(GAS v4u*)(F.MIX + (size_t)(seq0 + t) * 1024 + 512 + cc * 8) = o;
            if (r < 7) { const v4u a = w[r + 2 * HW], b = w[r];
                s0 += bflo(a.x) - bflo(b.x); s1 += bfhi(a.x) - bfhi(b.x); s2 += bflo(a.y) - bflo(b.y); s3 += bfhi(a.y) - bfhi(b.y); s4 += bflo(a.z) - bflo(b.z); s5 += bfhi(a.z) - bfhi(b.z); s6 += bflo(a.w) - bflo(b.w); s7 += bfhi(a.w) - bfhi(b.w); }
        }
    }
};
template <int HW> __device__ __forceinline__ void pool_wave(Frame& F, int g, int first, int stride) {
    constexpr int NRG = M / 32;
    if (HW <= 4 && first + 2 * stride < NRG && first + 3 * stride >= NRG) {
        PoolItem<HW> a, b; a.load(F, g, first, F.lane); b.load(F, g, first + stride, F.lane);
        a.finish(F); a.load(F, g, first + 2 * stride, F.lane); b.finish(F); a.finish(F);
    } else {
        for (int rg = first; rg < NRG; rg += stride) { PoolItem<HW> a; a.load(F, g, rg, F.lane); a.finish(F); }
    }
}
__device__ __forceinline__ void pool_role_big(Frame& F, int idx) { constexpr int NRG = M / 32;
    { PoolItem<8> a; a.load(F, 3, idx, F.lane); a.finish(F); }
    { PoolItem<8> b; b.load(F, 3, idx + NRG / 2, F.lane); b.finish(F); } }
__device__ __forceinline__ void pool_role_mid(Frame& F, int idx) { constexpr int NRG = M / 32;
    PoolItem<4> a, b, c; a.load(F, 2, idx, F.lane); b.load(F, 2, idx + NRG / 3, F.lane); a.finish(F); c.load(F, 2, idx + 2 * (NRG / 3), F.lane); b.finish(F); c.finish(F); }
__device__ __forceinline__ void pool_role_small(Frame& F, int idx) { constexpr int NRG = M / 32;
    PoolItem<2> a1, b1; PoolItem<1> a0, b0;
    a1.load(F, 1, idx, F.lane); b1.load(F, 1, idx + NRG / 2, F.lane); a1.finish(F); a0.load(F, 0, idx, F.lane); b1.finish(F); b0.load(F, 0, idx + NRG / 2, F.lane); a0.finish(F); b0.finish(F); }
__device__ __forceinline__ void pool_pass(Frame& F) {
    if (F.G == 256) {
        const int w = F.wave;
        if (w < 3) pool_role_big(F, F.vcu * 3 + w); else if (w < 5) pool_role_mid(F, F.vcu * 2 + (w - 3)); else pool_role_small(F, F.vcu * 3 + (w - 5));
        return;
    }
    const int gw = F.vcu * NWAVES + F.wave, NGW = F.G * NWAVES;
    const int g = gw & 3, first = gw >> 2, stride = NGW >> 2;
    if (g == 0) pool_wave<1>(F, 0, first, stride); else if (g == 1) pool_wave<2>(F, 1, first, stride); else if (g == 2) pool_wave<4>(F, 2, first, stride); else pool_wave<8>(F, 3, first, stride);
}

__device__ __forceinline__ void attn_decode(int L, long& rowbase, int& NT, int& h, int& qb, int& kvh) {
    const int i = L >> 8, v = L & 255, xcd = v >> 5, l = v & 31;
    if (i < 4) { const int combo = xcd * 2 + (i >> 1), b = combo >> 1; kvh = combo & 1; const int idx = (i & 1) * 32 + l; h = kvh * 4 + (idx >> 4); qb = idx & 15; rowbase = (long)b * 4096; NT = 64; }
    else { const int combo = xcd >> 1, b = combo >> 1; kvh = combo & 1; const int idx = (xcd & 1) * 64 + (i - 4) * 32 + l; h = kvh * 4 + (idx >> 5); qb = idx & 31; rowbase = (long)ROWS_P + (long)b * 8192; NT = 128; }
}
template <bool NOMAX> __device__ __forceinline__ void attn_all_t(Frame& F, char* lds, bf16* Obuf) {
    attn_body::bf16x8 qr[4] = {};
    bool first = true;
    for (int L = F.vcu; L < 1536; L += F.G) {
        long rowbase, n_rowbase; int NT, h, qb, kvh, n_NT, n_h, n_qb, n_kvh;
        attn_decode(L, rowbase, NT, h, qb, kvh);
        const bool has_next = L + F.G < 1536;
        attn_decode(has_next ? L + F.G : L, n_rowbase, n_NT, n_h, n_qb, n_kvh);
        const attn_body::bf16* Kh = (const attn_body::bf16*)F.KV + rowbase * 256 + kvh * 64;
        const attn_body::bf16* n_Kh = (const attn_body::bf16*)F.KV + n_rowbase * 256 + n_kvh * 64;
        attn_body::attn_unit<8, NOMAX>(rowbase, NT, h, qb, (const attn_body::bf16*)F.MIX, Kh, Kh + 128, (attn_body::bf16*)Obuf, lds, first, has_next, n_rowbase, n_h, n_qb, n_Kh, qr);
        first = false;
    }
}
__device__ __forceinline__ void attn_all(Frame& F, char* lds, bf16* Obuf) {
    float mq = 0.f, mk = 0.f;
    for (int i = 0; i < 64; ++i) { mq = fmaxf(mq, fabsf(F.qg[i])); mk = fmaxf(mk, fabsf(F.kg[i])); }
    const bool fast = 2.0f * (8.0f * 1.4426950408889634f) * mq * mk < 64.0f;
    if (fast) attn_all_t<true>(F, lds, Obuf); else attn_all_t<false>(F, lds, Obuf);
}

struct Args { const float* in[12]; float* out; unsigned char* ws; int ph_lo, ph_hi; };
__global__ void __launch_bounds__(NWAVES * 64, 2) mega_fwd(Args args) {
    extern __shared__ __attribute__((aligned(16))) unsigned char lds[];
    Frame F;
    F.lds = (LAS unsigned char*)lds;
    F.tid = threadIdx.x; F.lane = F.tid & 63; F.wave = __builtin_amdgcn_readfirstlane(F.tid >> 6);
    F.G = gridDim.x; { const int bx = blockIdx.x; F.vcu = (F.G % 8 == 0) ? (bx % 8) * (F.G / 8) + bx / 8 : bx; }
    unsigned char* ws = args.ws;
    F.xp = args.in[0]; F.xs = args.in[1]; F.g1 = args.in[2]; F.win = args.in[3]; F.qg = args.in[4]; F.kg = args.in[5]; F.wpool = args.in[6]; F.pscale = args.in[7];
    F.wout = args.in[8]; F.g2 = args.in[9]; F.wup = args.in[10]; F.wdn = args.in[11]; F.out = args.out;
    F.Win_t = (bf16*)(ws + WS_WIN); F.Wo_t = (bf16*)(ws + WS_WO); F.Wup_t = (bf16*)(ws + WS_WUP); F.Wdn_t = (bf16*)(ws + WS_WDN);
    F.XN = (bf16*)(ws + WS_XN); F.MIX = (bf16*)(ws + WS_MIX); F.KV = (bf16*)(ws + WS_KV); F.U = (bf16*)(ws + WS_U); F.H = (bf16*)(ws + WS_H);
    F.cosT = (float*)(ws + WS_ROPE); F.sinT = F.cosT + 2048; F.stats = (float*)(ws + WS_STATS); F.xinv = (float*)(ws + WS_XINV);
#if MK_N_LAUNCHES == 1
    cg::grid_group grid = cg::this_grid();
    for (int u = F.tid; u < (LDS_BYTES - LDSCTL_OFF) / 4; u += NWAVES * 64) ((LAS unsigned*)(F.lds + LDSCTL_OFF))[u] = 0u;
    __syncthreads();
    XcdBarrier bar = xcd_barrier_post((unsigned*)(ws + WS_CTL), (volatile LAS unsigned*)(F.lds + MISC_OFF) + 8);
#define GRID_BAR() do { if (args.ph_hi < 0) { asm volatile("s_waitcnt vmcnt(0)" ::: "memory"); grid.sync(); } else xcd_barrier(bar); } while (0)
#define GRID_BAR0() GRID_BAR()
#else
#define GRID_BAR0() do {} while (0)
#define GRID_BAR() do {} while (0)
#endif
    const int lo = args.ph_lo, hi = args.ph_hi < 0 ? -args.ph_hi : args.ph_hi;
#define IN(k) (lo <= (k) && (k) < hi)
#define BOTH(k) (IN(k) && IN((k) + 1))
    if (IN(0)) { p0_prologue(F);
#if PROBE_PH == 0
        p0_prologue(F);
#endif
        if (BOTH(0)) GRID_BAR0(); }
    if (IN(1)) {
        pg8::Gemm g{F.XN, F.Win_t, M, NIN, D}; pg8::StaticOrder S; S.init(M, NIN, F.G, (int)blockIdx.x);
        pg8::EpiInProj E{F.MIX, F.KV, F.U, F.qg, F.kg, F.cosT, F.sinT};
        pg8::gemm_phase<pg8::EpiInProj, pg8::StaticOrder, PG8_ALIGN, PG8_SP2>(F.lds + RING_OFF, g, S, E);
#if PROBE_PH == 1
        pg8::gemm_phase<pg8::EpiInProj, pg8::StaticOrder, PG8_ALIGN, PG8_SP2>(F.lds + RING_OFF, g, S, E);
#endif
        if (BOTH(1)) GRID_BAR();
    }
    if (IN(2)) {
        static_assert(attn_body::ATTN_LDS_BYTES <= RING_BYTES, "attention LDS");
        pool_pass(F);
#if PROBE_PH == 2
        attn_all(F, (char*)lds + RING_OFF, F.XN);
#endif
#if PROBE_PH == 7
        pool_pass(F);
#endif
        attn_all(F, (char*)lds + RING_OFF, F.MIX);
        if (BOTH(2)) GRID_BAR();
    }
    if (IN(3)) {
        pg8::Gemm g{F.MIX, F.Wo_t, M, D, D}; pg8::StaticOrder S; S.init(M, D, F.G, (int)blockIdx.x);
        const int g_ok = __syncthreads_and((fabsf(F.g1[F.tid]) >= 1e-3f && fabsf(F.g1[F.tid + 512]) >= 1e-3f) ? 1 : 0);
        if (g_ok) { pg8::EpiResStats<true> E{F.xp, F.xs, F.XN, F.stats, F.xinv, F.g1};
            pg8::gemm_phase<pg8::EpiResStats<true>, pg8::StaticOrder, PG8_ALIGN, PG8_SP2>(F.lds + RING_OFF, g, S, E); }
        else { pg8::EpiResStats<false> E{F.xp, F.xs, F.XN, F.stats, F.xinv, F.g1};
            pg8::gemm_phase<pg8::EpiResStats<false>, pg8::StaticOrder, PG8_ALIGN, PG8_SP2>(F.lds + RING_OFF, g, S, E); }
        if (BOTH(3)) GRID_BAR();
    }
    if (IN(4)) {
        pg8::Gemm g{F.XN, F.Wup_t, M, FF, D}; pg8::StaticOrder S; S.init(M, FF, F.G, (int)blockIdx.x);
        LAS float* tab = (LAS float*)(F.lds + UPTAB_OFF);
        { const int rowi = F.tid & 255;
          for (int i = F.tid >> 8; i < pg8::UP_TAB_ROUNDS; i += 2) { const int pm = S.pm_at(i); if (pm < 0) break;
              const f32x4* p = (const f32x4*)(F.stats + (size_t)(pm * 256 + rowi) * 16); const f32x4 a = p[0], b = p[1], c = p[2], d = p[3];
              const float ssum = ((a[0] + a[1]) + (a[2] + a[3])) + ((b[0] + b[1]) + (b[2] + b[3])) + ((c[0] + c[1]) + (c[2] + c[3])) + ((d[0] + d[1]) + (d[2] + d[3]));
              tab[i * 256 + rowi] = __builtin_amdgcn_rsqf(ssum * (1.0f / 1024.0f) + EPS); }
          __syncthreads(); }
        pg8::EpiUp E{F.H, F.stats, tab};
        pg8::gemm_phase<pg8::EpiUp, pg8::StaticOrder, PG8_ALIGN, PG8_SP2>(F.lds + RING_OFF, g, S, E);
#if PROBE_PH == 4
        pg8::gemm_phase<pg8::EpiUp, pg8::StaticOrder, PG8_ALIGN, PG8_SP2>(F.lds + RING_OFF, g, S, E);
#endif
        if (BOTH(4)) GRID_BAR();
    }
    if (IN(5)) {
        pg8::Gemm g{F.H, F.Wdn_t, M, D, FF}; pg8::StaticOrder S; S.init(M, D, F.G, (int)blockIdx.x, 1);
        pg8::EpiDown E{F.out, F.XN};
        pg8::gemm_phase<pg8::EpiDown, pg8::StaticOrder, PG8_ALIGN, PG8_SP2>(F.lds + RING_OFF, g, S, E);
#if PROBE_PH == 5
        pg8::gemm_phase<pg8::EpiDown, pg8::StaticOrder, PG8_ALIGN, PG8_SP2>(F.lds + RING_OFF, g, S, E);
#endif
    }
#undef IN
#undef BOTH
}

extern "C" void kernel_launch(void* const* d_in, const int* in_sizes, int n_in, void* d_out, int out_size, void* d_ws, size_t ws_size, hipStream_t stream) {
    static int grid = 0;
    if (grid == 0) {
        if (n_in != 12 || in_sizes[0] != ROWS_P * D || in_sizes[1] != (M - ROWS_P) * D || out_size != M * D || ws_size < WS_END) {
            fprintf(stderr, "kernel_launch: shape / workspace mismatch (n_in %d, out %d, ws %zu < %zu); nothing launched\n", n_in, out_size, ws_size, (size_t)WS_END); grid = -1; return; }
        int dev = 0, cus = 0, per_cu = 0;
        if (hipGetDevice(&dev) != hipSuccess || hipDeviceGetAttribute(&cus, hipDeviceAttributeMultiprocessorCount, dev) != hipSuccess) { grid = -1; return; }
        if (hipFuncSetAttribute((const void*)mega_fwd, hipFuncAttributeMaxDynamicSharedMemorySize, LDS_BYTES) != hipSuccess) { fprintf(stderr, "kernel_launch: hipFuncSetAttribute failed\n"); grid = -1; return; }
        if (hipOccupancyMaxActiveBlocksPerMultiprocessor(&per_cu, (const void*)mega_fwd, NWAVES * 64, LDS_BYTES) != hipSuccess || per_cu < 1) { fprintf(stderr, "kernel_launch: occupancy query says %d\n", per_cu); per_cu = 1; }
        (void)hipGetLastError();
        grid = cus * per_cu;
    }
    if (grid < 0) return;
    Args a{};
    for (int i = 0; i < 12; ++i) a.in[i] = (const float*)d_in[i];
    a.out = (float*)d_out; a.ws = (unsigned char*)d_ws;
#if MK_N_LAUNCHES == 1
    a.ph_lo = 0; a.ph_hi = PER_PHASE;
    if (hipMemsetAsync((char*)d_ws + WS_CTL, 0, CTL_ZERO_BYTES, stream) != hipSuccess) { fprintf(stderr, "kernel_launch: memset of the barrier words failed\n"); return; }
    void* kargs[] = {&a};
    hipError_t e = hipLaunchCooperativeKernel((const void*)mega_fwd, dim3(grid), dim3(NWAVES * 64), kargs, LDS_BYTES, stream);
    if (e != hipSuccess) fprintf(stderr, "kernel_launch: cooperative launch failed: %s (grid %d)\n", hipGetErrorString(e), grid);
#else
    for (int li = 0; li < PER_PHASE; ++li) { a.ph_lo = li; a.ph_hi = li + 1; hipLaunchKernelGGL(mega_fwd, dim3(grid), dim3(NWAVES * 64), LDS_BYTES, stream, a); }
#endif
}
```

```cpp
#define MK_N_LAUNCHES 1
#include <hip/hip_runtime.h>
#include <hip/hip_cooperative_groups.h>
#include <cstdio>
#include <cstdint>
namespace cg = cooperative_groups;
namespace pg8 {
#define PG8_LAS __attribute__((address_space(3)))
typedef unsigned short bf16_t;
typedef short bf16x8 __attribute__((ext_vector_type(8)));
typedef float f32x4 __attribute__((ext_vector_type(4)));
typedef unsigned u32x4 __attribute__((ext_vector_type(4)));
constexpr int BM = 256, BK = 64, HALF = 128, HTB = HALF * BK * 2  , STAGE_BYTES = 8 * HTB, NXCD = 8, WGM = 8;

__host__ __device__ __forceinline__ int lds_byte(int r, int c) { const int st = (r >> 4) * 2 + (c >> 5), rr = r & 15, cc = c & 31, ob = rr * 64 + cc * 2; return st * 1024 + (ob ^ (((ob >> 9) & 1) << 5)); }
__host__ __device__ __forceinline__ void stage_rc(int b, int& R, int& C) { const int st = b / 1024, sb = b % 1024, swz = sb ^ (((sb >> 9) & 1) << 5); R = (st >> 1) * 16 + swz / 64; C = (st & 1) * 32 + (swz % 64) / 2; }
__host__ __device__ __forceinline__ int perm32(int rho) { const int n = rho >> 4, i = rho & 15; return 8 * (i >> 2) + 4 * n + (i & 3); }

struct Unit { int pm, pn, idx; };
struct Gemm { const bf16_t* A; const bf16_t* Bt; int M, N, K; };

struct StaticOrder {
    int nM, nN, nwg, G, c, R, rev;
    __host__ __device__ void init(int M, int N, int G_, int c_, int rev_ = 0) { nM = M / BM; nN = N / BM; nwg = nM * nN; G = G_; c = c_; R = (nwg + G - 1) / G; rev = rev_; }
    __host__ __device__ bool next(int i, Unit& u) const {
        if (i >= R) return false;
        const long L = (long)(rev ? R - 1 - i : i) * G + c; if (L >= nwg) return false;
        int wgid = (int)L; { const int q = nwg / NXCD, r = nwg % NXCD, xcd = wgid % NXCD, off = wgid / NXCD; wgid = (xcd < r ? xcd * (q + 1) : r * (q + 1) + (xcd - r) * q) + off; }
        const int nig = WGM * nN, gid = wgid / nig, fm = gid * WGM, gsz = (nM - fm) < WGM ? (nM - fm) : WGM;
        u.pm = fm + ((wgid % nig) % gsz); u.pn = (wgid % nig) / gsz; u.idx = i; return true;
    }
    __device__ __forceinline__ int pm_at(int i) const {
        if (i >= R) return -1;
        const long L = (long)(rev ? R - 1 - i : i) * G + c; if (L >= nwg) return -1;
        int wgid = (int)L; { const int q = nwg / NXCD, r = nwg % NXCD, xcd = wgid % NXCD, off = wgid / NXCD; wgid = (xcd < r ? xcd * (q + 1) : r * (q + 1) + (xcd - r) * q) + off; }
        const int nig = WGM * nN, gid = wgid / nig, fm = gid * WGM, gsz = (nM - fm) < WGM ? (nM - fm) : WGM;
        return fm + ((wgid % nig) % gsz);
    }
    __device__ __forceinline__ void a_ready(const Unit&) const {}
    __device__ __forceinline__ void done(const Unit&) const {}
};

__device__ __forceinline__ unsigned cvt_pk_bf16(float lo, float hi) { unsigned r; asm volatile("v_cvt_pk_bf16_f32 %0, %1, %2" : "=v"(r) : "v"(lo), "v"(hi)); return r; }

typedef float f32x2 __attribute__((ext_vector_type(2)));
typedef unsigned u32x2 __attribute__((ext_vector_type(2)));
constexpr int ROWS_PROMPT = 8 * 4096;
constexpr float RMS_EPS = 1e-6f;
constexpr float QK_C2 = 0.125f * 1.4426950408889634f;

struct EpiInProj {
    static constexpr bool PERM = true, AFTER_DRAIN = false;
    bf16_t* MIX; bf16_t* KV; bf16_t* U; const float* qg; const float* kg; const float* cosT; const float* sinT;
    __device__ __forceinline__ void operator()(const f32x4 (&acc)[2][2][4][2], const Unit& u, int wr, int wc, int fr, int fq) const {
        const int row0 = u.pm * BM + wr * 64 + fr;
        if (u.pn >= 3 || (u.pn == 2 && wc >= 2)) {
            bf16_t* base; int pitch;
            if (u.pn >= 3) { base = U + (size_t)row0 * 512 + (u.pn - 3) * 256 + wc * 32 + 8 * fq; pitch = 512; }
            else { base = KV + (size_t)row0 * 256 + 128 + (wc - 2) * 64 + 8 * fq; pitch = 256; }
            const int bjs = (u.pn >= 3) ? HALF : 32;
#pragma unroll
            for (int ai = 0; ai < 2; ++ai)
#pragma unroll
                for (int m = 0; m < 4; ++m) { bf16_t* rowp = base + (size_t)(ai * HALF + m * 16) * pitch;
#pragma unroll
                    for (int bj = 0; bj < 2; ++bj) { const f32x4 v0 = acc[ai][bj][m][0], v1 = acc[ai][bj][m][1];
                        u32x4 w; w.x = cvt_pk_bf16(v0[0], v0[1]); w.y = cvt_pk_bf16(v0[2], v0[3]); w.z = cvt_pk_bf16(v1[0], v1[1]); w.w = cvt_pk_bf16(v1[2], v1[3]);
                        *(u32x4*)(rowp + bj * bjs) = w; } }
            return;
        }
        const bool isK = (u.pn == 2);
        const float* g = isK ? kg : qg; const float sc = isK ? 1.f : QK_C2;
        bf16_t* base; int pitch;
        if (isK) { base = KV + (size_t)row0 * 256 + wc * 64 + 8 * fq; pitch = 256; } else { base = MIX + (size_t)row0 * 1024 + (u.pn * 4 + wc) * 64 + 8 * fq; pitch = 1024; }
        f32x4 gv[2][2];
#pragma unroll
        for (int bj = 0; bj < 2; ++bj)
#pragma unroll
            for (int n = 0; n < 2; ++n) gv[bj][n] = *(const f32x4*)(g + 32 * bj + 16 * n + 4 * fq) * sc;
        const int rowt = u.pm * BM; const int t0 = rowt < ROWS_PROMPT ? (rowt & 4095) : ((rowt - ROWS_PROMPT) & 8191);
        const int prow_base = (t0 >> 6) + wr;
#pragma unroll
        for (int ai = 0; ai < 2; ++ai) {
            const int prow = prow_base + 2 * ai;
            const f32x4 cr = *(const f32x4*)(cosT + prow * 16 + 4 * fq), sr = *(const f32x4*)(sinT + prow * 16 + 4 * fq);
#pragma unroll
            for (int m = 0; m < 4; ++m) {
                const int pcol = 16 * m + fr;
                const f32x4 cc = *(const f32x4*)(cosT + pcol * 16 + 4 * fq), sn = *(const f32x4*)(sinT + pcol * 16 + 4 * fq);
                float ss = 0.f;
#pragma unroll
                for (int bj = 0; bj < 2; ++bj)
#pragma unroll
                    for (int n = 0; n < 2; ++n) { const f32x4 x = acc[ai][bj][m][n]; ss += (x[0] * x[0] + x[1] * x[1]) + (x[2] * x[2] + x[3] * x[3]); }
                ss += __shfl_xor(ss, 16); ss += __shfl_xor(ss, 32);
                const float rstd = __builtin_amdgcn_rsqf(ss * (1.0f / 64.0f) + RMS_EPS);
                bf16_t* rowp = base + (size_t)(ai * HALF + m * 16) * pitch;
#pragma unroll
                for (int bj = 0; bj < 2; ++bj) { const f32x4 c = bj == 0 ? cr : cc, s = bj == 0 ? sr : sn;
                    const f32x4 y0 = acc[ai][bj][m][0] * rstd * gv[bj][0], y1 = acc[ai][bj][m][1] * rstd * gv[bj][1];
                    const f32x4 o0 = y0 * c - y1 * s, o1 = y1 * c + y0 * s;
                    u32x4 w; w.x = cvt_pk_bf16(o0[0], o0[1]); w.y = cvt_pk_bf16(o0[2], o0[3]); w.z = cvt_pk_bf16(o1[0], o1[1]); w.w = cvt_pk_bf16(o1[2], o1[3]);
                    *(u32x4*)(rowp + bj * 32) = w; }
            }
        }
    }
};

template <bool RECON> struct EpiResStats {
    static constexpr bool PERM = true, AFTER_DRAIN = false;
    const float* xp; const float* xs; bf16_t* xb; float* stats; const float* xinv; const float* g1;
    __device__ __forceinline__ void operator()(const f32x4 (&acc)[2][2][4][2], const Unit& u, int wr, int wc, int fr, int fq) const {
        const int rowt = u.pm * BM; const float* base = rowt < ROWS_PROMPT ? xp : xs - (size_t)ROWS_PROMPT * 1024;
        const int col0 = u.pn * BM + wc * 32 + 8 * fq;
        f32x4 gi[2][2];
        if constexpr (RECON) {
#pragma unroll
            for (int bj = 0; bj < 2; ++bj)
#pragma unroll
                for (int n = 0; n < 2; ++n) { const f32x4 g = *(const f32x4*)(g1 + col0 + bj * HALF + n * 4); gi[bj][n] = (f32x4){__builtin_amdgcn_rcpf(g[0]), __builtin_amdgcn_rcpf(g[1]), __builtin_amdgcn_rcpf(g[2]), __builtin_amdgcn_rcpf(g[3])}; }
        }
#pragma unroll
        for (int ai = 0; ai < 2; ++ai)
#pragma unroll
            for (int m = 0; m < 4; ++m) { const int r = rowt + ai * HALF + wr * 64 + m * 16 + fr; const size_t off = (size_t)r * 1024 + col0; float ss = 0.f;
                float xi = 0.f; if constexpr (RECON) xi = xinv[r];
#pragma unroll
                for (int bj = 0; bj < 2; ++bj) { f32x4 b0, b1;
                    if constexpr (RECON) { const u32x4 w = *(const u32x4*)(xb + off + bj * HALF);
                        b0 = (f32x4){__builtin_bit_cast(float, w.x << 16), __builtin_bit_cast(float, w.x & 0xffff0000u), __builtin_bit_cast(float, w.y << 16), __builtin_bit_cast(float, w.y & 0xffff0000u)} * xi * gi[bj][0];
                        b1 = (f32x4){__builtin_bit_cast(float, w.z << 16), __builtin_bit_cast(float, w.z & 0xffff0000u), __builtin_bit_cast(float, w.w << 16), __builtin_bit_cast(float, w.w & 0xffff0000u)} * xi * gi[bj][1]; }
                    else { b0 = *(const f32x4*)(base + off + bj * HALF); b1 = *(const f32x4*)(base + off + bj * HALF + 4); }
                    const f32x4 o0 = b0 + acc[ai][bj][m][0], o1 = b1 + acc[ai][bj][m][1];
                    ss += ((o0[0] * o0[0] + o0[1] * o0[1]) + (o0[2] * o0[2] + o0[3] * o0[3])) + ((o1[0] * o1[0] + o1[1] * o1[1]) + (o1[2] * o1[2] + o1[3] * o1[3]));
                    u32x4 w2; w2.x = cvt_pk_bf16(o0[0], o0[1]); w2.y = cvt_pk_bf16(o0[2], o0[3]); w2.z = cvt_pk_bf16(o1[0], o1[1]); w2.w = cvt_pk_bf16(o1[2], o1[3]); *(u32x4*)(xb + off + bj * HALF) = w2; }
                ss += __shfl_xor(ss, 16); ss += __shfl_xor(ss, 32);
                if (fq == 0) stats[(size_t)r * 16 + u.pn * 4 + wc] = ss;
                if (!RECON && m == 3) asm volatile("" ::: "memory"); }
    }
};

constexpr int UP_TAB_ROUNDS = 12;
struct EpiUp {
    static constexpr bool PERM = true, AFTER_DRAIN = false;
    bf16_t* H; const float* stats; const PG8_LAS float* tab;
    __device__ __forceinline__ void operator()(const f32x4 (&acc)[2][2][4][2], const Unit& u, int wr, int wc, int fr, int fq) const {
        const int row0 = u.pm * BM + wr * 64 + fr; const int col0 = u.pn * BM + wc * 32 + 8 * fq;
#pragma unroll
        for (int ai = 0; ai < 2; ++ai)
#pragma unroll
            for (int m = 0; m < 4; ++m) { const int r = row0 + ai * HALF + m * 16;
                float rstd;
                if (u.idx < UP_TAB_ROUNDS) rstd = tab[u.idx * BM + ai * HALF + wr * 64 + m * 16 + fr];
                else { const f32x4 p = *(const f32x4*)(stats + (size_t)r * 16 + 4 * fq); float s = (p[0] + p[1]) + (p[2] + p[3]);
                    s += __shfl_xor(s, 16); s += __shfl_xor(s, 32); rstd = __builtin_amdgcn_rsqf(s * (1.0f / 1024.0f) + RMS_EPS); }
                bf16_t* rowp = H + (size_t)r * 4096 + col0;
#pragma unroll
                for (int bj = 0; bj < 2; ++bj) { f32x4 v0 = acc[ai][bj][m][0] * rstd, v1 = acc[ai][bj][m][1] * rstd;
#pragma unroll
                    for (int e = 0; e < 4; ++e) { const float a = fmaxf(v0[e], 0.f), b = fmaxf(v1[e], 0.f); v0[e] = a * a; v1[e] = b * b; }
                    u32x4 w; w.x = cvt_pk_bf16(v0[0], v0[1]); w.y = cvt_pk_bf16(v0[2], v0[3]); w.z = cvt_pk_bf16(v1[0], v1[1]); w.w = cvt_pk_bf16(v1[2], v1[3]);
                    *(u32x4*)(rowp + bj * HALF) = w; } }
    }
};

struct EpiDown {
    static constexpr bool PERM = true, AFTER_DRAIN = false;
    float* out; const bf16_t* xb;
    __device__ __forceinline__ void operator()(const f32x4 (&acc)[2][2][4][2], const Unit& u, int wr, int wc, int fr, int fq) const {
        const int col0 = u.pn * BM + wc * 32 + 8 * fq;
#pragma unroll
        for (int ai = 0; ai < 2; ++ai)
#pragma unroll
            for (int m = 0; m < 4; ++m) { const int r = u.pm * BM + ai * HALF + wr * 64 + m * 16 + fr; const size_t off = (size_t)r * 1024 + col0;
#pragma unroll
                for (int bj = 0; bj < 2; ++bj) { const u32x4 w = __builtin_nontemporal_load((const u32x4*)(xb + off + bj * HALF));
                    const f32x4 b0 = {__builtin_bit_cast(float, w.x << 16), __builtin_bit_cast(float, w.x & 0xffff0000u), __builtin_bit_cast(float, w.y << 16), __builtin_bit_cast(float, w.y & 0xffff0000u)};
                    const f32x4 b1 = {__builtin_bit_cast(float, w.z << 16), __builtin_bit_cast(float, w.z & 0xffff0000u), __builtin_bit_cast(float, w.w << 16), __builtin_bit_cast(float, w.w & 0xffff0000u)};
                    __builtin_nontemporal_store(b0 + acc[ai][bj][m][0], (f32x4*)(out + off + bj * HALF)); __builtin_nontemporal_store(b1 + acc[ai][bj][m][1], (f32x4*)(out + off + bj * HALF + 4)); } }
    }
};

template <class Epi, class Sched, bool ALIGN_EPI = false, bool SP2 = false>
__device__ __forceinline__ void gemm_phase(PG8_LAS unsigned char* lds, const Gemm g, const Sched& S, const Epi& E) {
    const int tid = threadIdx.x, wid = __builtin_amdgcn_readfirstlane(tid >> 6), lane = tid & 63, wr = wid >> 2, wc = wid & 3, fr = lane & 15, fq = lane >> 4;
    const int K = g.K, nt = K / BK;
    unsigned voffA[2], voffB[2];
#pragma unroll
    for (int i = 0; i < 2; ++i) { int R, C; stage_rc(tid * 16 + i * 8192, R, C); const int Rb = Epi::PERM ? ((R & ~31) + perm32(R & 31)) : R;
        voffA[i] = (unsigned)(R * K + C) * 2u; voffB[i] = (unsigned)(Rb * K + C) * 2u; }
    const size_t kstep = (size_t)(BK * 2);
    const size_t hstep = (size_t)HALF * K * 2;
    const size_t tstep = 2 * hstep;
    const unsigned ldsw = (unsigned)wid * 1024u;
    const int aoff = lds_byte(wr * 64 + fr, fq * 8), boff = lds_byte(wc * 32 + fr, fq * 8);
#define PG8_SA(b, h) (((b) * 2 + (h)) * HTB)
#define PG8_SB(b, h) ((4 + (b) * 2 + (h)) * HTB)
#define PG8_STAGE(bufoff, gbase, voff) do { _Pragma("unroll") for (int _i = 0; _i < 2; ++_i) \
        __builtin_amdgcn_global_load_lds((const unsigned*)((const char*)(gbase) + (voff)[_i]), (PG8_LAS unsigned*)(lds + (bufoff) + ldsw + _i * 8192), 16, 0, 0); } while (0)
#define PG8_LDA(dst, b, h) do { _Pragma("unroll") for (int m = 0; m < 4; ++m) _Pragma("unroll") for (int k = 0; k < 2; ++k) dst[m][k] = *(const PG8_LAS bf16x8*)(lds + PG8_SA(b, h) + aoff + m * 2048 + k * 1024); } while (0)
#define PG8_LDB(dst, b, h) do { _Pragma("unroll") for (int n = 0; n < 2; ++n) _Pragma("unroll") for (int k = 0; k < 2; ++k) dst[n][k] = *(const PG8_LAS bf16x8*)(lds + PG8_SB(b, h) + boff + n * 2048 + k * 1024); } while (0)
#define PG8_MMA(ai, bj, At, Bt) do { __builtin_amdgcn_s_setprio(1); _Pragma("unroll") for (int m = 0; m < 4; ++m) _Pragma("unroll") for (int n = 0; n < 2; ++n) _Pragma("unroll") for (int k = 0; k < 2; ++k) \
        acc[ai][bj][m][n] = __builtin_amdgcn_mfma_f32_16x16x32_bf16(Bt[n][k], At[m][k], acc[ai][bj][m][n], 0, 0, 0); __builtin_amdgcn_s_setprio(0); } while (0)
#define PG8_WAIT_V(n) asm volatile("s_waitcnt vmcnt(" #n ")" ::: "memory")
#define PG8_WAIT_L(n) asm volatile("s_waitcnt lgkmcnt(" #n ")" ::: "memory")
#define PG8_BAR __builtin_amdgcn_s_barrier()
#define PG8_SCHED __builtin_amdgcn_sched_barrier(0)
    Unit cur, nxt; int ui = 0;
    if (!S.next(0, cur)) return;
    f32x4 acc[2][2][4][2];
#pragma unroll
    for (int a = 0; a < 2; ++a)
#pragma unroll
        for (int b = 0; b < 2; ++b)
#pragma unroll
            for (int m = 0; m < 4; ++m)
#pragma unroll
                for (int n = 0; n < 2; ++n) acc[a][b][m][n] = (f32x4){0.f, 0.f, 0.f, 0.f};
    bf16x8 At[4][2], B0[2][2], B1[2][2];
    const char* cA = (const char*)g.A + (size_t)cur.pm * tstep; const char* cB = (const char*)g.Bt + (size_t)cur.pn * tstep;
    S.a_ready(cur);
    if constexpr (SP2) {
        PG8_STAGE(PG8_SB(0, 0), cB, voffB); PG8_STAGE(PG8_SB(0, 1), cB + hstep, voffB); PG8_STAGE(PG8_SA(0, 0), cA, voffA); PG8_STAGE(PG8_SA(0, 1), cA + hstep, voffA);
        if (wr == 1) PG8_BAR;
        PG8_WAIT_V(2); PG8_BAR;
        PG8_STAGE(PG8_SB(1, 0), cB + kstep, voffB); PG8_STAGE(PG8_SA(1, 0), cA + kstep, voffA); PG8_STAGE(PG8_SB(1, 1), cB + hstep + kstep, voffB);
        PG8_WAIT_V(6); PG8_BAR;
    } else {
        PG8_STAGE(PG8_SB(0, 0), cB, voffB); PG8_STAGE(PG8_SA(0, 0), cA, voffA); PG8_STAGE(PG8_SB(0, 1), cB + hstep, voffB); PG8_STAGE(PG8_SA(0, 1), cA + hstep, voffA);
        if (wr == 1) PG8_BAR;
        PG8_WAIT_V(4); PG8_BAR;
        PG8_STAGE(PG8_SB(1, 0), cB + kstep, voffB); PG8_STAGE(PG8_SA(1, 0), cA + kstep, voffA); PG8_STAGE(PG8_SB(1, 1), cB + hstep + kstep, voffB);
        PG8_WAIT_V(6); PG8_BAR;
    }
    for (;;) {
        const bool has_next = S.next(ui + 1, nxt);
        const char* nA = has_next ? (const char*)g.A + (size_t)nxt.pm * tstep : cA; const char* nB = has_next ? (const char*)g.Bt + (size_t)nxt.pn * tstep : cB;
        for (int t = 0; t < nt; t += 2) {
            const bool last = (t == nt - 2);
            const char* a1 = cA + (size_t)(t + 1) * kstep;
            const char* a2 = last ? nA : cA + (size_t)(t + 2) * kstep; const char* b2 = last ? nB : cB + (size_t)(t + 2) * kstep;
            const char* a3 = a2 + kstep; const char* b3 = b2 + kstep;
            if (last && has_next) S.a_ready(nxt);
            if constexpr (SP2) {
            PG8_LDB(B0, 0, 0); PG8_LDB(B1, 0, 1); PG8_SCHED; PG8_LDA(At, 0, 0); PG8_STAGE(PG8_SA(1, 1), a1 + hstep, voffA);
            PG8_WAIT_V(8); PG8_WAIT_L(0); PG8_BAR; PG8_MMA(0, 0, At, B0); PG8_MMA(0, 1, At, B1); PG8_BAR; PG8_SCHED;
            PG8_LDA(At, 0, 1); PG8_STAGE(PG8_SB(0, 0), b2, voffB); PG8_STAGE(PG8_SB(0, 1), b2 + hstep, voffB); PG8_STAGE(PG8_SA(0, 0), a2, voffA);
            PG8_WAIT_V(8); PG8_WAIT_L(0); PG8_BAR; PG8_MMA(1, 0, At, B0); PG8_MMA(1, 1, At, B1); PG8_BAR; PG8_SCHED;
            PG8_LDB(B0, 1, 0); PG8_LDB(B1, 1, 1); PG8_SCHED; PG8_LDA(At, 1, 0); PG8_STAGE(PG8_SA(0, 1), a2 + hstep, voffA);
            PG8_WAIT_V(8); PG8_WAIT_L(0); PG8_BAR; PG8_MMA(0, 0, At, B0); PG8_MMA(0, 1, At, B1); PG8_BAR; PG8_SCHED;
            PG8_LDA(At, 1, 1); PG8_STAGE(PG8_SB(1, 0), b3, voffB); PG8_STAGE(PG8_SB(1, 1), b3 + hstep, voffB); PG8_STAGE(PG8_SA(1, 0), a3, voffA);
            PG8_WAIT_V(8); PG8_WAIT_L(0); PG8_BAR; PG8_MMA(1, 0, At, B0); PG8_MMA(1, 1, At, B1); PG8_BAR; PG8_SCHED;
            } else {
            PG8_LDB(B0, 0, 0); PG8_SCHED; PG8_LDA(At, 0, 0); PG8_STAGE(PG8_SA(1, 1), a1 + hstep, voffA);
            PG8_WAIT_L(8); PG8_BAR; PG8_WAIT_L(0); PG8_MMA(0, 0, At, B0); PG8_BAR; PG8_SCHED;
            PG8_LDB(B1, 0, 1); PG8_STAGE(PG8_SB(0, 0), b2, voffB);
            PG8_BAR; PG8_WAIT_L(0); PG8_MMA(0, 1, At, B1); PG8_BAR;
            PG8_LDA(At, 0, 1); PG8_STAGE(PG8_SA(0, 0), a2, voffA);
            PG8_BAR; PG8_WAIT_L(0); PG8_MMA(1, 0, At, B0); PG8_BAR; PG8_SCHED;
            PG8_STAGE(PG8_SB(0, 1), b2 + hstep, voffB);
            PG8_WAIT_V(6); PG8_BAR; PG8_MMA(1, 1, At, B1); PG8_BAR;
            PG8_LDB(B0, 1, 0); PG8_SCHED; PG8_LDA(At, 1, 0); PG8_STAGE(PG8_SA(0, 1), a2 + hstep, voffA);
            PG8_WAIT_L(8); PG8_BAR; PG8_WAIT_L(0); PG8_MMA(0, 0, At, B0); PG8_BAR; PG8_SCHED;
            PG8_LDB(B1, 1, 1); PG8_STAGE(PG8_SB(1, 0), b3, voffB);
            PG8_BAR; PG8_WAIT_L(0); PG8_MMA(0, 1, At, B1); PG8_BAR;
            PG8_LDA(At, 1, 1); PG8_STAGE(PG8_SA(1, 0), a3, voffA);
            PG8_BAR; PG8_WAIT_L(0); PG8_MMA(1, 0, At, B0); PG8_BAR; PG8_SCHED;
            PG8_STAGE(PG8_SB(1, 1), b3 + hstep, voffB);
            PG8_WAIT_V(6); PG8_BAR; PG8_MMA(1, 1, At, B1); PG8_BAR;
            }
        }
        if constexpr (ALIGN_EPI) { if (wr == 0) PG8_BAR; }
        if constexpr (!Epi::AFTER_DRAIN) { E(acc, cur, wr, wc, fr, fq); S.done(cur); }
        if (!has_next) break;
#pragma unroll
        for (int a = 0; a < 2; ++a)
#pragma unroll
            for (int b = 0; b < 2; ++b)
#pragma unroll
                for (int m = 0; m < 4; ++m)
#pragma unroll
                    for (int n = 0; n < 2; ++n) acc[a][b][m][n] = (f32x4){0.f, 0.f, 0.f, 0.f};
        cur = nxt; cA = nA; cB = nB; ++ui;
        if constexpr (ALIGN_EPI) { if (wr == 1) PG8_BAR; }
    }
    PG8_WAIT_V(0);
    if constexpr (!ALIGN_EPI) { if (wr == 0) PG8_BAR; }
    PG8_BAR;
    if constexpr (Epi::AFTER_DRAIN) { E.fused(acc, cur, wr, wc, fr, fq, lds, wid, lane); S.done(cur); }
#undef PG8_SA
#undef PG8_SB
#undef PG8_STAGE
#undef PG8_LDA
#undef PG8_LDB
#undef PG8_MMA
#undef PG8_WAIT_V
#undef PG8_WAIT_L
#undef PG8_BAR
#undef PG8_SCHED
}
}

#ifndef PG8_SP2
#define PG8_SP2 true
#endif
#ifndef PG8_ALIGN
#define PG8_ALIGN true
#endif
#include <hip/hip_bf16.h>
#include <cmath>
namespace attn_body {
using bf16=__hip_bfloat16;
using bf16x8=__attribute__((ext_vector_type(8)))short;
using s16x4=__attribute__((ext_vector_type(4)))short;
using f32x16=__attribute__((ext_vector_type(16)))float;
using u32x4=__attribute__((ext_vector_type(4)))unsigned;
constexpr int D=64,QP=1024,KP=256;
constexpr int NW=8,QBLK=32,QB=QBLK*NW,KVBLK=64;
constexpr int ATTN_UNIT_ROWS=QB;
__device__ __forceinline__ int crow(int r,int hi){return (r&3)+8*(r>>2)+4*hi;}
#define SBAR() __builtin_amdgcn_sched_barrier(0)
constexpr int NSLOT=3, SLOTB=8192;
constexpr int LDS_K=0, LDS_V=NSLOT*SLOTB, LDS_WS=2*NSLOT*SLOTB, LDS_OST=LDS_WS+NW*64*4, LDS_BYTES=LDS_OST+NW*4096;
constexpr float C2=0.125f*1.4426950408889634f;
__device__ __forceinline__ void glds16(const void*gsrc,unsigned lds_dst){unsigned keep;
  asm volatile("s_mov_b32 %0, m0\n\ts_mov_b32 m0, %2\n\ts_nop 0\n\tglobal_load_lds_dwordx4 %1, off\n\ts_mov_b32 m0, %0":"=&s"(keep):"v"(gsrc),"s"(lds_dst):"memory");}
__device__ __forceinline__ float max3f(float a,float b,float c){float r;asm("v_max3_f32 %0, %1, %2, %3":"=v"(r):"v"(a),"v"(b),"v"(c));return r;}
__device__ __forceinline__ float max2f(float a,float b){float r;asm("v_max_f32_e32 %0, %1, %2":"=v"(r):"v"(a),"v"(b));return r;}
__device__ __forceinline__ float fadd_s(float a,float b){float r;asm("v_add_f32_e32 %0, %1, %2":"=v"(r):"v"(a),"v"(b));return r;}
__device__ __forceinline__ float fsub_s(float a,float b){float r;asm("v_sub_f32_e32 %0, %1, %2":"=v"(r):"v"(a),"v"(b));return r;}
typedef float f32x2_t __attribute__((ext_vector_type(2))); typedef __bf16 bf16x2_t __attribute__((ext_vector_type(2)));
__device__ __forceinline__ unsigned cvtpk_s(float lo,float hi){f32x2_t v={lo,hi};bf16x2_t b=__builtin_convertvector(v,bf16x2_t);return __builtin_bit_cast(unsigned,b);}
#define WAIT_BAR(N) asm volatile("s_waitcnt vmcnt(" #N ") lgkmcnt(0)\n\ts_barrier":::"memory")

__device__ __forceinline__ void qkt(f32x16&p0,f32x16&p1,const char*Kslot,const bf16x8*qr,const f32x16&negm,int r32,int hi){
  const char*kb=Kslot+hi*1024+r32*16;
  #pragma unroll
  for(int d0=0;d0<4;++d0){
    const bf16x8 b0=*reinterpret_cast<const bf16x8*>(kb+d0*2048);
    const bf16x8 b1=*reinterpret_cast<const bf16x8*>(kb+d0*2048+512);
    if(d0==0){p0=__builtin_amdgcn_mfma_f32_32x32x16_bf16(b0,qr[0],negm,0,0,0);p1=__builtin_amdgcn_mfma_f32_32x32x16_bf16(b1,qr[0],negm,0,0,0);}
    else{p0=__builtin_amdgcn_mfma_f32_32x32x16_bf16(b0,qr[d0],p0,0,0,0);p1=__builtin_amdgcn_mfma_f32_32x32x16_bf16(b1,qr[d0],p1,0,0,0);}}
}
typedef __attribute__((address_space(3))) const char* lds_cptr;
typedef short v4i16_t __attribute__((ext_vector_type(4)));
__device__ __forceinline__ void kload8(bf16x8*kf,lds_cptr kp){
  kf[0]=*(const __attribute__((address_space(3))) bf16x8*)(kp);      kf[1]=*(const __attribute__((address_space(3))) bf16x8*)(kp+512);
  kf[2]=*(const __attribute__((address_space(3))) bf16x8*)(kp+2048); kf[3]=*(const __attribute__((address_space(3))) bf16x8*)(kp+2560);
  kf[4]=*(const __attribute__((address_space(3))) bf16x8*)(kp+4096); kf[5]=*(const __attribute__((address_space(3))) bf16x8*)(kp+4608);
  kf[6]=*(const __attribute__((address_space(3))) bf16x8*)(kp+6144); kf[7]=*(const __attribute__((address_space(3))) bf16x8*)(kp+6656);
}
__device__ __forceinline__ void kload2(bf16x8*kf,lds_cptr kp,int j){ kf[2*j]=*(const __attribute__((address_space(3))) bf16x8*)(kp+j*2048); kf[2*j+1]=*(const __attribute__((address_space(3))) bf16x8*)(kp+j*2048+512); }
__device__ __forceinline__ s16x4 vtr(lds_cptr p){ return __builtin_bit_cast(s16x4,__builtin_amdgcn_ds_read_tr16_b64_v4i16((__attribute__((address_space(3))) v4i16_t*)p)); }
__device__ __forceinline__ float rowmax(const f32x16&p0,const f32x16&p1){
  float a=max3f(p0[0],p0[1],p1[0]),b=max3f(p0[2],p0[3],p1[1]);a=max3f(a,p1[2],p1[3]);
  #pragma unroll
  for(int r=4;r<16;r+=4){a=max3f(a,p0[r],p0[r+1]);b=max3f(b,p0[r+2],p0[r+3]);a=max3f(a,p1[r],p1[r+1]);b=max3f(b,p1[r+2],p1[r+3]);}
  const float m=max2f(a,b);
  auto rr=__builtin_amdgcn_permlane32_swap(__float_as_uint(m),__float_as_uint(m),false,false);
  return max2f(__uint_as_float(rr[0]),__uint_as_float(rr[1]));
}
__device__ __forceinline__ void pv(f32x16*o,int vb,bf16x8 pa0,bf16x8 pa1,bf16x8 pa2,bf16x8 pa3){
  #pragma unroll
  for(int d0=0;d0<2;++d0){s16x4 lo[4],hi[4];
    #pragma unroll
    for(int ks=0;ks<4;++ks){
      asm volatile("ds_read_b64_tr_b16 %0,%1 offset:%c2":"=&v"(lo[ks]):"v"(vb),"i"(d0*4096+ks*1024):"memory");
      asm volatile("ds_read_b64_tr_b16 %0,%1 offset:%c2":"=&v"(hi[ks]):"v"(vb),"i"(d0*4096+ks*1024+512):"memory");}
    asm volatile("s_waitcnt lgkmcnt(0)":::"memory");SBAR();
    #define PK(k) (bf16x8){lo[k][0],lo[k][1],lo[k][2],lo[k][3],hi[k][0],hi[k][1],hi[k][2],hi[k][3]}
    o[d0]=__builtin_amdgcn_mfma_f32_32x32x16_bf16(pa0,PK(0),o[d0],0,0,0);
    o[d0]=__builtin_amdgcn_mfma_f32_32x32x16_bf16(pa1,PK(1),o[d0],0,0,0);
    o[d0]=__builtin_amdgcn_mfma_f32_32x32x16_bf16(pa2,PK(2),o[d0],0,0,0);
    o[d0]=__builtin_amdgcn_mfma_f32_32x32x16_bf16(pa3,PK(3),o[d0],0,0,0);
    #undef PK
  }
}

#ifndef ATTN_STORE16
#define ATTN_STORE16(p,v) (*(u32x4*)(p)=(v))
#endif
template<int THRL,bool NOMAX> __device__ __forceinline__ void attn_unit(long rowbase,int NT,int h,int qb,const bf16*Q,const bf16*__restrict__ Kh,const bf16*__restrict__ Vh,bf16*O,char*shm,
    bool first,bool has_next,long n_rowbase,int n_h,int n_qb,const bf16*__restrict__ n_Kh,bf16x8 (&qr)[4]){
  const int tid=threadIdx.x,lane=tid&63,r32=lane&31,hi=lane>>5; const int wid=__builtin_amdgcn_readfirstlane(tid>>6);
  const int q0=qb*QB;
  const bf16*Qw=Q+(rowbase+q0+wid*QBLK)*QP+h*D;
  const unsigned lds0=(unsigned)(uintptr_t)shm;
  float*wsf=(float*)(shm+LDS_WS)+wid*64;
  const bf16*ksrc=Kh+(long)lane*KP+wid*8;
  const bf16*vsrc=Vh+(long)(16*(wid&3)+(lane>>2))*KP+(wid>>2)*32+(lane&3)*8;
  const unsigned kdst=lds0+LDS_K+wid*1024, vdst=lds0+LDS_V+wid*1024;
  #define DMA_K(t,slot) glds16(ksrc+(long)(t)*KVBLK*KP,(unsigned)__builtin_amdgcn_readfirstlane(kdst+(slot)))
  #define DMA_V(t,slot) glds16(vsrc+(long)(t)*KVBLK*KP,(unsigned)__builtin_amdgcn_readfirstlane(vdst+(slot)))
  const int vb0=(int)(lds0+LDS_V)+((lane>>4)&1)*32+(lane&3)*8+(4*hi+((lane&15)>>2))*64;
  const char*Kbase=shm+LDS_K; bf16x8 kf[8];
  const lds_cptr shm3=(lds_cptr)shm; const lds_cptr kp0=shm3+LDS_K+hi*1024+r32*16; const lds_cptr vp0=shm3+LDS_V+((lane>>4)&1)*32+(lane&3)*8+(4*hi+((lane&15)>>2))*64;
  if(first){ DMA_K(0,0);DMA_V(0,0);DMA_K(1,SLOTB);
  #pragma unroll
  for(int d0=0;d0<4;++d0)qr[d0]=*reinterpret_cast<const bf16x8*>(&Qw[(long)r32*QP+d0*16+hi*8]); }
  float mhat=0.f,l_reg=0.f;f32x16 o[2];o[0]=f32x16{};o[1]=f32x16{};f32x16 negm=f32x16{};asm volatile("":"+v"(negm));
  #define CMASK(P0,P1,t) do{}while(0)
  bool resc=false;
  #define START(P0,P1) do{ const float rm=rowmax(P0,P1); resc=false; \
    { const float dl=rm; mhat=fadd_s(mhat,dl); \
      _Pragma("unroll") for(int r=0;r<16;++r){P0[r]=fsub_s(P0[r],dl);P1[r]=fsub_s(P1[r],dl);} \
      _Pragma("unroll") for(int r=0;r<16;++r)negm[r]=-mhat; asm volatile("":"+v"(negm)); } \
    _Pragma("unroll") for(int r=0;r<16;++r)P0[r]=__builtin_amdgcn_exp2f(P0[r]); }while(0)
  #define RESC() do{ if(resc){ asm volatile("s_waitcnt lgkmcnt(0)":::"memory"); \
      _Pragma("unroll") for(int d_=0;d_<2;++d_) _Pragma("unroll") for(int r=0;r<16;++r)o[d_][r]*=wsf[crow(r,hi)]; } }while(0)
  f32x16 pA0,pA1,pB0,pB1;
  int sl_prev=0,sl_cur=0,sl_next=SLOTB;
  #define ROT() do{sl_prev=sl_cur;sl_cur=sl_next;sl_next=(sl_next==(NSLOT-1)*SLOTB)?0:sl_next+SLOTB;}while(0)
  if(first){ DMA_K(2,2*SLOTB);
  WAIT_BAR(3); }
  else { DMA_V(0,0); WAIT_BAR(1); }
  qkt(pA0,pA1,Kbase,qr,negm,r32,hi);asm volatile("s_nop 15\n\ts_nop 7":"+v"(pA0),"+v"(pA1));CMASK(pA0,pA1,0);
  START(pA0,pA1);
  _Pragma("unroll") for(int r=0;r<16;++r)pA1[r]=__builtin_amdgcn_exp2f(pA1[r]);
  WAIT_BAR(0);
  DMA_K(3,0);DMA_V(1,SLOTB);
  ROT();
  kload8(kf,kp0+sl_cur);
  WAIT_BAR(2);
  s16x4 vlo[8],vhi[8]; u32x4 pw0,pw1,pw2,pw3;
  #define PKW(P,B) cvtpk_s(P[B],P[B+1])
  #define PAF(k) __builtin_bit_cast(bf16x8,pw##k)
  #define VFR(i) (bf16x8){vlo[i][0],vlo[i][1],vlo[i][2],vlo[i][3],vhi[i][0],vhi[i][1],vhi[i][2],vhi[i][3]}
  #define PIN(x) asm volatile("":"+v"(x))
  #define MX3(a,b,c) __builtin_fmaxf(__builtin_fmaxf((a),(b)),(c))
  #define GAPA(MF,A0,A1,A2,A3,W0,W1,PW) do{ MF; sacc+=A0; sacc+=A1; sacc+=A2; sacc+=A3; PIN(sacc); W0; W1; PIN(PW); SBAR(); }while(0)
  #define EX(v) __builtin_amdgcn_exp2f(v)
  #define GAPB(MF,X,B) do{ MF; X[B]=EX(X[B]); X[B+1]=EX(X[B+1]); X[B+2]=EX(X[B+2]); X[B+3]=EX(X[B+3]); PIN(X); SBAR(); }while(0)
  #define VRD(i) do{ vlo[i]=vtr(vp_+(((i)>>2)*4096+((i)&3)*1024)); vhi[i]=vtr(vp_+(((i)>>2)*4096+((i)&3)*1024+512)); }while(0)
  #define KRD(G,j) do{ if(G){ kload2(kf,kp0+sl_next,j); SBAR(); } }while(0)
  #define STEP(C0,C1,P0,P1,t,GK,GV,GL) do{ SBAR(); \
    const lds_cptr vp_=vp0+sl_prev; \
    VRD(0); SBAR(); float sacc=(P0[0]+P0[1]); \
    GAPA(C0=__builtin_amdgcn_mfma_f32_32x32x16_bf16(kf[0],qr[0],negm,0,0,0), P0[2],P0[3],P0[4],P0[5],     pw0[0]=PKW(P0,0), pw0[1]=PKW(P0,2), pw0); \
    VRD(4); SBAR(); GAPA(C1=__builtin_amdgcn_mfma_f32_32x32x16_bf16(kf[1],qr[0],negm,0,0,0), P0[6],P0[7],P0[8],P0[9],     pw0[2]=PKW(P0,4), pw0[3]=PKW(P0,6), pw0); \
    VRD(1); SBAR(); GAPA(C0=__builtin_amdgcn_mfma_f32_32x32x16_bf16(kf[2],qr[1],C0,0,0,0),   P0[10],P0[11],P0[12],P0[13], pw1[0]=PKW(P0,8), pw1[1]=PKW(P0,10), pw1); \
    VRD(5); SBAR(); GAPA(C1=__builtin_amdgcn_mfma_f32_32x32x16_bf16(kf[3],qr[1],C1,0,0,0),   P0[14],P0[15],P1[0],P1[1],   pw1[2]=PKW(P0,12),pw1[3]=PKW(P0,14), pw1); \
    VRD(2); SBAR(); GAPA(C0=__builtin_amdgcn_mfma_f32_32x32x16_bf16(kf[4],qr[2],C0,0,0,0),   P1[2],P1[3],P1[4],P1[5],     pw2[0]=PKW(P1,0), pw2[1]=PKW(P1,2), pw2); \
    VRD(6); SBAR(); GAPA(C1=__builtin_amdgcn_mfma_f32_32x32x16_bf16(kf[5],qr[2],C1,0,0,0),   P1[6],P1[7],P1[8],P1[9],     pw2[2]=PKW(P1,4), pw2[3]=PKW(P1,6), pw2); \
    VRD(3); SBAR(); GAPA(C0=__builtin_amdgcn_mfma_f32_32x32x16_bf16(kf[6],qr[3],C0,0,0,0),   P1[10],P1[11],P1[12],P1[13], pw3[0]=PKW(P1,8), pw3[1]=PKW(P1,10), pw3); \
    VRD(7); SBAR(); GAPA(C1=__builtin_amdgcn_mfma_f32_32x32x16_bf16(kf[7],qr[3],C1,0,0,0),   P1[14],P1[15],0.f,0.f,       pw3[2]=PKW(P1,12),pw3[3]=PKW(P1,14), pw3); \
    l_reg+=sacc; \
    if(GK){DMA_K((t)+3,sl_cur);} if(GV){DMA_V((t)+1,sl_next);} \
    CMASK(C0,C1,t); \
    if constexpr(NOMAX){ resc=false; } else { float a=MX3(C0[0],C0[1],C1[0]),b=MX3(C0[2],C0[3],C1[1]); a=MX3(a,C1[2],C1[3]); \
      _Pragma("unroll") for(int r=4;r<16;r+=4){a=MX3(a,C0[r],C0[r+1]);b=MX3(b,C0[r+2],C0[r+3]);a=MX3(a,C1[r],C1[r+1]);b=MX3(b,C1[r+2],C1[r+3]);} \
      float rm=__builtin_fmaxf(a,b); { auto rr=__builtin_amdgcn_permlane32_swap(__float_as_uint(rm),__float_as_uint(rm),false,false); rm=__builtin_fmaxf(__uint_as_float(rr[0]),__uint_as_float(rr[1])); } \
      resc=false; \
      if(__builtin_expect(__any(rm>(float)THRL),0)){ const float dl=__builtin_fmaxf(rm,0.f); mhat+=dl; \
        _Pragma("unroll") for(int r=0;r<16;++r){C0[r]-=dl;C1[r]-=dl;} \
        _Pragma("unroll") for(int r=0;r<16;++r)negm[r]=-mhat; asm volatile("":"+v"(negm)); \
        const float f=__builtin_amdgcn_exp2f(-dl); l_reg*=f; if(hi==0)wsf[r32]=f; resc=true; } } \
    SBAR(); \
    GAPB(o[0]=__builtin_amdgcn_mfma_f32_32x32x16_bf16(PAF(0),VFR(0),o[0],0,0,0), C0,0); \
    GAPB(o[1]=__builtin_amdgcn_mfma_f32_32x32x16_bf16(PAF(0),VFR(4),o[1],0,0,0), C0,4); \
    KRD(GL,0); GAPB(o[0]=__builtin_amdgcn_mfma_f32_32x32x16_bf16(PAF(1),VFR(1),o[0],0,0,0), C0,8); \
    KRD(GL,1); GAPB(o[1]=__builtin_amdgcn_mfma_f32_32x32x16_bf16(PAF(1),VFR(5),o[1],0,0,0), C0,12); \
    KRD(GL,2); GAPB(o[0]=__builtin_amdgcn_mfma_f32_32x32x16_bf16(PAF(2),VFR(2),o[0],0,0,0), C1,0); \
    KRD(GL,3); GAPB(o[1]=__builtin_amdgcn_mfma_f32_32x32x16_bf16(PAF(2),VFR(6),o[1],0,0,0), C1,4); \
    GAPB(o[0]=__builtin_amdgcn_mfma_f32_32x32x16_bf16(PAF(3),VFR(3),o[0],0,0,0), C1,8); \
    GAPB(o[1]=__builtin_amdgcn_mfma_f32_32x32x16_bf16(PAF(3),VFR(7),o[1],0,0,0), C1,12); \
    }while(0)
  int t=1;
  #undef CMASK
  #define CMASK(P0,P1,t) do{}while(0)
  for(;t+5<NT;t+=2){
    STEP(pB0,pB1,pA0,pA1,t,true,true,true);     WAIT_BAR(2); RESC(); ROT();
    STEP(pA0,pA1,pB0,pB1,t+1,true,true,true);   WAIT_BAR(2); RESC(); ROT();
  }
  #undef CMASK
  #define CMASK(P0,P1,t) do{}while(0)
  #define ENDW(tt) do{ if((tt)+3<NT){WAIT_BAR(2);} else if((tt)+2<NT){WAIT_BAR(1);} else {WAIT_BAR(0);} }while(0)
  for(;t+1<NT;t+=2){
    STEP(pB0,pB1,pA0,pA1,t,(t+3<NT),(t+1<NT),(t+1<NT));       ENDW(t);   RESC(); ROT();
    STEP(pA0,pA1,pB0,pB1,t+1,(t+4<NT),(t+2<NT),(t+2<NT));     ENDW(t+1); RESC(); ROT();
  }
  if(has_next){ const bf16*ksn=n_Kh+(long)lane*KP+wid*8;
    glds16(ksn,(unsigned)__builtin_amdgcn_readfirstlane(kdst)); glds16(ksn+(long)KVBLK*KP,(unsigned)__builtin_amdgcn_readfirstlane(kdst+SLOTB)); glds16(ksn+(long)2*KVBLK*KP,(unsigned)__builtin_amdgcn_readfirstlane(kdst+2*SLOTB)); }
  STEP(pB0,pB1,pA0,pA1,NT-1,false,false,false);
  if(has_next){ const bf16*Qn=Q+(n_rowbase+n_qb*QB+wid*QBLK)*QP+n_h*D;
    _Pragma("unroll") for(int d0=0;d0<4;++d0)qr[d0]=*reinterpret_cast<const bf16x8*>(&Qn[(long)r32*QP+d0*16+hi*8]); }
  RESC();
  { float sacc=pB0[0]+pB0[1]; _Pragma("unroll") for(int r=2;r<16;++r)sacc+=pB0[r]; _Pragma("unroll") for(int r=0;r<16;++r)sacc+=pB1[r]; l_reg+=sacc;
    pw0=(u32x4){PKW(pB0,0),PKW(pB0,2),PKW(pB0,4),PKW(pB0,6)};pw1=(u32x4){PKW(pB0,8),PKW(pB0,10),PKW(pB0,12),PKW(pB0,14)};pw2=(u32x4){PKW(pB1,0),PKW(pB1,2),PKW(pB1,4),PKW(pB1,6)};pw3=(u32x4){PKW(pB1,8),PKW(pB1,10),PKW(pB1,12),PKW(pB1,14)};
    SBAR(); pv(o,vb0+sl_cur,PAF(0),PAF(1),PAF(2),PAF(3)); }
  #undef PKW
  #undef PAF
  #undef VFR
  #undef PIN
  #undef MX3
  #undef GAPA
  #undef GAPB
  #undef EX
  #undef VRD
  #undef KRD
  #undef STEP
  #undef ENDW
  {auto rr=__builtin_amdgcn_permlane32_swap(__float_as_uint(l_reg),__float_as_uint(l_reg),false,false);l_reg=__uint_as_float(rr[0])+__uint_as_float(rr[1]);}
  if(hi==0)wsf[32+r32]=l_reg;asm volatile("s_waitcnt lgkmcnt(0)":::"memory");
  float rli[16];
  #pragma unroll
  for(int r=0;r<16;++r)rli[r]=__builtin_amdgcn_rcpf(wsf[32+crow(r,hi)]);
  bf16*Ow=O+(rowbase+q0+wid*QBLK)*QP+h*D;
  { bf16*stg=(bf16*)(shm+LDS_OST)+wid*2048;
    #pragma unroll
    for(int r=0;r<16;++r){const int orow=crow(r,hi);
      #pragma unroll
      for(int d0=0;d0<2;++d0)stg[orow*64+d0*32+r32]=__float2bfloat16(o[d0][r]*rli[r]);}
    asm volatile("s_waitcnt lgkmcnt(0)":::"memory");
    #pragma unroll
    for(int i=0;i<4;++i){const int row=i*8+(lane>>3),ch=lane&7; const u32x4 v=*(const u32x4*)(stg+row*64+ch*8); ATTN_STORE16(Ow+(long)row*QP+ch*8,v);} }
  asm volatile("s_waitcnt lgkmcnt(0)\n\ts_barrier":::"memory");
  #undef DMA_K
  #undef DMA_V
  #undef CMASK
  #undef START
  #undef RESC
  #undef ROT
}
constexpr int ATTN_LDS_BYTES=LDS_BYTES;
#undef SBAR
#undef WAIT_BAR
}
constexpr int NWAVES = 8;
#ifndef MK_N_LAUNCHES
#define MK_N_LAUNCHES 1
#endif
#ifndef PROBE_PH
#define PROBE_PH -1
#endif
constexpr int N_LAUNCHES = MK_N_LAUNCHES;
constexpr int PER_PHASE = 6;

constexpr int D = 1024, FF = 4096, NIN = 1280, HD = 64;
constexpr int M = 49152;
constexpr int ROWS_P = 32768;
constexpr float EPS = 1e-6f;

constexpr size_t MiB = 1u << 20;
constexpr size_t WS_CTL = 0, CTL_ZERO_BYTES = 16384;
constexpr size_t WS_ROPE = 1 * MiB;
constexpr size_t WS_XINV = WS_ROPE + 65536;
constexpr size_t WS_STATS = 2 * MiB;
constexpr size_t WS_WIN = 6 * MiB, WS_WO = 9 * MiB, WS_WUP = 11 * MiB, WS_WDN = 19 * MiB;
constexpr size_t WS_XN = 32 * MiB;
constexpr size_t WS_MIX = 128 * MiB;
constexpr size_t WS_KV = 224 * MiB;
constexpr size_t WS_U = 248 * MiB;
constexpr size_t WS_H = 128 * MiB;
constexpr size_t WS_END = 512 * MiB;
static_assert(WS_WDN + (size_t)D * FF * 2 <= WS_XN && WS_XN + (size_t)M * D * 2 <= WS_MIX && WS_U + (size_t)M * 512 * 2 <= WS_END && WS_H + (size_t)M * FF * 2 <= WS_END && WS_STATS + (size_t)M * 64 <= WS_WIN, "d_ws map");

constexpr int RING_OFF = 0, RING_BYTES = 131072;
constexpr int LDSCTL_OFF = RING_BYTES, MISC_OFF = LDSCTL_OFF + 320;
constexpr int UPTAB_OFF = RING_BYTES + 2048;
constexpr int LDS_BYTES = 147456;
static_assert(UPTAB_OFF + 12 * 256 * 4 <= LDS_BYTES, "LDS map");

#define GAS __attribute__((address_space(1)))
#define LAS __attribute__((address_space(3)))
typedef unsigned short bf16;
typedef unsigned v4u __attribute__((ext_vector_type(4)));
typedef float f32x4 __attribute__((ext_vector_type(4)));
#define LDS_WAIT() asm volatile("s_waitcnt lgkmcnt(0)" ::: "memory")
__device__ __forceinline__ unsigned f2bf(float f) { unsigned u = __builtin_bit_cast(unsigned, f); return (u + 0x7fffu + ((u >> 16) & 1u)) >> 16; }
typedef float f32x2_pk __attribute__((ext_vector_type(2))); typedef __bf16 bf16x2_pk __attribute__((ext_vector_type(2)));
__device__ __forceinline__ unsigned pk2(float lo, float hi) { const f32x2_pk v = {lo, hi}; return __builtin_bit_cast(unsigned, __builtin_convertvector(v, bf16x2_pk)); }
__device__ __forceinline__ float bflo(unsigned w) { return __builtin_bit_cast(float, w << 16); }
__device__ __forceinline__ float bfhi(unsigned w) { return __builtin_bit_cast(float, w & 0xffff0000u); }

#define XB_TMO      128
#define XB_XCNT(j)  (256  + 64 * (j))
#define XB_XSUB(j)  (1280 + 64 * (j))
#define XB_XGEN(j)  (2304 + 64 * (j))
#define XB_TOP      3328
#define XB_TOPGEN   3392
#define XCD_BAR_WORDS 3456
#define XB_SPIN_CAP (1u << 18)

__device__ __forceinline__ unsigned xb_ld(unsigned* p)              { return __hip_atomic_load(p, __ATOMIC_RELAXED, __HIP_MEMORY_SCOPE_AGENT); }
__device__ __forceinline__ unsigned xb_add(unsigned* p, unsigned v) { return __hip_atomic_fetch_add(p, v, __ATOMIC_RELAXED, __HIP_MEMORY_SCOPE_AGENT); }
__device__ __forceinline__ unsigned xb_xcc_id() { return (unsigned)__builtin_amdgcn_s_getreg((3 << 11) | 20) & 0xFu; }
#define XB_SPIN(cond, bar) do { unsigned _sp = 0; while (cond) { __builtin_amdgcn_s_sleep(1); \
    if ((++_sp & 255u) == 0u) { if (xb_ld(&(bar)[XB_TMO])) break; if (_sp > XB_SPIN_CAP) { atomicAdd(&(bar)[XB_TMO], 1u); break; } } } } while (0)

struct XcdBarrier {
    unsigned* bar; unsigned x;
    volatile LAS unsigned* st;
};

__device__ __forceinline__ XcdBarrier xcd_barrier_post(unsigned* bar, volatile LAS unsigned* st) {
    XcdBarrier b; b.bar = bar; b.x = xb_xcc_id(); b.st = st;
    if (threadIdx.x == 0) (void)xb_add(&bar[XB_XCNT(b.x)], 1u);
    return b;
}
__device__ __forceinline__ void xcd_barrier_complete(unsigned* bar, unsigned x, unsigned& nloc, unsigned& nx) {
    const unsigned G = gridDim.x * gridDim.y * gridDim.z;
    unsigned sum, cnt, mine, sp = 0u;
    for (;;) {
        sum = 0u; cnt = 0u; mine = 0u;
#pragma unroll
        for (unsigned j = 0; j < 16; ++j) { const unsigned c = xb_ld(&bar[XB_XCNT(j)]); sum += c; cnt += (c > 0u) ? 1u : 0u; mine = (j == x) ? c : mine; }
        if (sum == G) break;
        __builtin_amdgcn_s_sleep(1);
        if ((++sp & 255u) == 0u) { if (xb_ld(&bar[XB_TMO])) break; if (sp > XB_SPIN_CAP) { atomicAdd(&bar[XB_TMO], 1u); break; } }
    }
    nloc = mine > 0u ? mine : 1u; nx = cnt > 0u ? cnt : 1u;
}

__device__ __forceinline__ void xcd_barrier(const XcdBarrier& b) {
    asm volatile("s_waitcnt vmcnt(0)" ::: "memory");
    __syncthreads();
    if (threadIdx.x == 0) {
        unsigned* bar = b.bar;
        __builtin_amdgcn_s_waitcnt(0);
        unsigned nloc = b.st[0], nx = b.st[1];
        if (nloc == 0u) { xcd_barrier_complete(bar, b.x, nloc, nx); b.st[0] = nloc; b.st[1] = nx; }
        const unsigned old = xb_add(&bar[XB_XSUB(b.x)], 1u);
        const unsigned gen = old / nloc;
        if (old + 1u == (gen + 1u) * nloc) {
            __builtin_amdgcn_fence(__ATOMIC_RELEASE, "agent");
            asm volatile("s_waitcnt vmcnt(0)" ::: "memory");
            const unsigned og = xb_add(&bar[XB_TOP], 1u);
            const unsigned tg = og / nx;
            if (og + 1u == (tg + 1u) * nx) xb_add(&bar[XB_TOPGEN], 1u);
            else XB_SPIN(xb_ld(&bar[XB_TOPGEN]) == tg, bar);
            __builtin_amdgcn_fence(__ATOMIC_ACQUIRE, "agent");
            xb_add(&bar[XB_XGEN(b.x)], 1u);
            asm volatile("s_waitcnt vmcnt(0)" ::: "memory");
        } else {
            XB_SPIN(xb_ld(&bar[XB_XGEN(b.x)]) == gen, bar);
            __builtin_amdgcn_fence(__ATOMIC_ACQUIRE, "agent");
            asm volatile("s_waitcnt vmcnt(0)" ::: "memory");
        }
    }
    __syncthreads();
}

struct Frame {
    LAS unsigned char* lds;
    int tid, lane, wave, vcu, G;
    const float *xp, *xs, *g1, *win, *qg, *kg, *wpool, *pscale, *wout, *g2, *wup, *wdn;
    float* out;
    bf16 *Win_t, *Wo_t, *Wup_t, *Wdn_t, *XN, *MIX, *KV, *U, *H;
    float *cosT, *sinT, *stats, *xinv;
};

__device__ __forceinline__ float wave_sum(float v) {
#pragma unroll
    for (int o = 1; o < 64; o <<= 1) v += __shfl_xor(v, o);
    return v;
}
__device__ __forceinline__ int inproj_dst_row(int A) {
    const int pn = A >> 8, a = A & 255;
    if (pn >= 3) return A;
    const int bj = (a >> 5) & 1, i = a & 31, head = a >> 6;
    int c;
    if (pn == 2 && a >= 128) c = 128 * bj + 32 * head + i;
    else c = 128 * bj + 32 * head + 8 * ((i >> 2) & 3) + 4 * (i >> 4) + (i & 3);
    return 256 * pn + c;
}
template <int MODE> __device__ __forceinline__ void p0_transpose_item(const float* W, int N, bf16* WT, int ldt, const float* kscale, LAS float* scr, int item, int lane) {
    const int nblk = N / 32, kb = item / nblk, nb = item % nblk, k0 = 64 * kb, n0 = 32 * nb;
#pragma unroll
    for (int i = 0; i < 32; ++i) { const int kk = 2 * i + (lane >> 5); float v = W[(size_t)(k0 + kk) * N + n0 + (lane & 31)]; if (kscale) v *= kscale[k0 + kk]; scr[kk * 33 + (lane & 31)] = v; }
    LDS_WAIT(); asm volatile("" ::: "memory");
    const int c = lane & 7;
#pragma unroll
    for (int j = 0; j < 4; ++j) { const int n = (lane >> 3) + 8 * j; const LAS float* s = scr + (8 * c) * 33 + n;
        v4u o; o.x = pk2(s[0 * 33], s[1 * 33]); o.y = pk2(s[2 * 33], s[3 * 33]); o.z = pk2(s[4 * 33], s[5 * 33]); o.w = pk2(s[6 * 33], s[7 * 33]);
        const int dr = MODE == 1 ? inproj_dst_row(n0 + n) : (n0 + n);
        *(GAS v4u*)(WT + (size_t)dr * ldt + k0 + 8 * c) = o; }
    LDS_WAIT(); asm volatile("" ::: "memory");
}
__device__ __forceinline__ void titem_load(const float* tW, int tN, int tr, int lane, float (&v)[32]) {
    const int nblk = tN / 32, kb = tr / nblk, nb = tr % nblk, k0 = 64 * kb, n0 = 32 * nb;
#pragma unroll
    for (int i = 0; i < 32; ++i) { const int kk = 2 * i + (lane >> 5); v[i] = __builtin_nontemporal_load(tW + (size_t)(k0 + kk) * tN + n0 + (lane & 31)); }
}
__device__ __forceinline__ void titem_store(int tN, bf16* tWT, int tldt, const float* tks, int tmode, int tr, LAS float* scr, int lane, const float (&v)[32]) {
    const int nblk = tN / 32, kb = tr / nblk, nb = tr % nblk, k0 = 64 * kb, n0 = 32 * nb;
#pragma unroll
    for (int i = 0; i < 32; ++i) { const int kk = 2 * i + (lane >> 5); float x = v[i]; if (tks) x *= tks[k0 + kk]; scr[kk * 33 + (lane & 31)] = x; }
    LDS_WAIT(); asm volatile("" ::: "memory");
    const int c = lane & 7;
#pragma unroll
    for (int j = 0; j < 4; ++j) { const int n = (lane >> 3) + 8 * j; const LAS float* sp = scr + (8 * c) * 33 + n;
        v4u o; o.x = pk2(sp[0 * 33], sp[1 * 33]); o.y = pk2(sp[2 * 33], sp[3 * 33]); o.z = pk2(sp[4 * 33], sp[5 * 33]); o.w = pk2(sp[6 * 33], sp[7 * 33]);
        const int dr = tmode == 1 ? inproj_dst_row(n0 + n) : (n0 + n);
        *(GAS v4u*)(tWT + (size_t)dr * tldt + k0 + 8 * c) = o; }
    LDS_WAIT(); asm volatile("" ::: "memory");
}
__device__ __forceinline__ void rms_row_to_bf16(Frame& F, const f32x4 (&v)[4], bf16* orow, float* xinv_row) {
    const GAS f32x4* gr = (const GAS f32x4*)F.g1 + 2 * F.lane;
    float s = 0.f;
#pragma unroll
    for (int j = 0; j < 4; ++j) { s += (v[j].x * v[j].x + v[j].y * v[j].y) + (v[j].z * v[j].z + v[j].w * v[j].w); }
    const float ms = wave_sum(s) * (1.f / D) + EPS, rstd = __builtin_amdgcn_rsqf(ms), rms = ms * rstd;
    if (F.lane == 0) *xinv_row = rms;
    GAS v4u* o16 = (GAS v4u*)orow + F.lane;
#pragma unroll
    for (int j = 0; j < 2; ++j) { const f32x4 ga = gr[128 * j], gb = gr[128 * j + 1]; const f32x4 ya = v[2 * j] * rstd * ga, yb = v[2 * j + 1] * rstd * gb;
        v4u o; o.x = pk2(ya.x, ya.y); o.y = pk2(ya.z, ya.w); o.z = pk2(yb.x, yb.y); o.w = pk2(yb.z, yb.w); o16[64 * j] = o; }
}
constexpr int P0_WW = 2;
__device__ __forceinline__ void p0_prologue(Frame& F) {
    LAS float* scr = (LAS float*)(F.lds + RING_OFF + F.wave * 16384);
    if (F.wave < P0_WW) {
    const int gw = F.vcu * P0_WW + F.wave, NGW = F.G * P0_WW;
    const int gt = gw * 64 + F.lane, NGT = NGW * 64;
    for (int it = gt; it < 2048; it += NGT) {
        const int pos = it >> 4, f = it & 15; double invf = 1.0;
        for (int i = 0; i < f; ++i) invf *= 0.5623413251903491;
        const double a = (double)pos * invf, k = __builtin_rint(a * 0.15915494309189535), r = a - k * 6.283185307179586, r2 = r * r;
        double s = 1.0, c = 1.0;
        for (int i = 16; i >= 1; --i) { s = 1.0 - s * r2 / (double)((2 * i) * (2 * i + 1)); c = 1.0 - c * r2 / (double)((2 * i - 1) * (2 * i)); }
        s *= r; F.cosT[it] = (float)c; F.sinT[it] = (float)s;
    }
    for (int it = gt; it < 128 * 1024; it += NGT) {
        const int jb = __builtin_amdgcn_readfirstlane(it >> 10), n = it & 1023, g = jb >> 5, jj0 = (jb & 31) * 4;
        const float* wp = F.wpool + ((size_t)g * 128 + jj0) * 128; const float* ps = F.pscale + g * 128; const float* wo = F.wout + (size_t)(512 + g * 128) * 1024 + n;
        float a0 = 0.f, a1 = 0.f, a2 = 0.f, a3 = 0.f;
        for (int e0 = 0; e0 < 128; e0 += 32) { float w[32];
#pragma unroll
            for (int i = 0; i < 32; ++i) w[i] = wo[(size_t)(e0 + i) * 1024];
#pragma unroll
            for (int i = 0; i < 32; ++i) { const float ww = w[i] * ps[e0 + i]; a0 += wp[0 * 128 + e0 + i] * ww; a1 += wp[1 * 128 + e0 + i] * ww; a2 += wp[2 * 128 + e0 + i] * ww; a3 += wp[3 * 128 + e0 + i] * ww; } }
        typedef unsigned v2u __attribute__((ext_vector_type(2)));
        v2u o; o.x = pk2(a0, a1); o.y = pk2(a2, a3);
        *(GAS v2u*)(F.Wo_t + (size_t)n * 1024 + 512 + jb * 4) = o;
    }
    constexpr int I_IN = (D / 64) * (NIN / 32), I_O = (512 / 64) * (D / 32), I_UP = (D / 64) * (FF / 32), I_DN = (FF / 64) * (D / 32);
    constexpr int NITEMS = I_IN + I_O + I_UP + I_DN;
#define P0_DECODE(p, it_) const float* p##W; int p##N; bf16* p##WT; int p##ldt; const float* p##ks; int p##mode; int p##r; { int r_ = (it_); \
        if (r_ < I_IN) { p##W = F.win; p##N = NIN; p##WT = F.Win_t; p##ldt = D; p##ks = nullptr; p##mode = 1; p##r = r_; } \
        else if (r_ < I_IN + I_O) { p##W = F.wout; p##N = D; p##WT = F.Wo_t; p##ldt = D; p##ks = nullptr; p##mode = 0; p##r = r_ - I_IN; } \
        else if (r_ < I_IN + I_O + I_UP) { p##W = F.wup; p##N = FF; p##WT = F.Wup_t; p##ldt = D; p##ks = F.g2; p##mode = 0; p##r = r_ - I_IN - I_O; } \
        else { p##W = F.wdn; p##N = D; p##WT = F.Wdn_t; p##ldt = FF; p##ks = nullptr; p##mode = 0; p##r = r_ - I_IN - I_O - I_UP; } }
    for (int it = gw; it < NITEMS; it += 2 * NGW) {
        const int it2 = it + NGW; const bool two = it2 < NITEMS;
        P0_DECODE(ta, it) P0_DECODE(tb, two ? it2 : it)
        float va[32], vb[32];
        titem_load(taW, taN, tar, F.lane, va); titem_load(tbW, tbN, tbr, F.lane, vb);
        titem_store(taN, taWT, taldt, taks, tamode, tar, scr, F.lane, va); if (two) titem_store(tbN, tbWT, tbldt, tbks, tbmode, tbr, scr, F.lane, vb);
    }
#undef P0_DECODE
    } else {
    const int gw = F.vcu * (NWAVES - P0_WW) + (F.wave - P0_WW), NGW = F.G * (NWAVES - P0_WW);
    for (int m = gw; m < M; m += 4 * NGW) {
        f32x4 v[4][4];
#pragma unroll
        for (int q = 0; q < 4; ++q) { const int mm = m + q * NGW; if (mm < M) { const float* xrow = mm < ROWS_P ? F.xp + (size_t)mm * D : F.xs + (size_t)(mm - ROWS_P) * D; const GAS f32x4* xr = (const GAS f32x4*)xrow + 2 * F.lane;
#pragma unroll
            for (int j = 0; j < 2; ++j) { v[q][2 * j] = __builtin_nontemporal_load(xr + 128 * j); v[q][2 * j + 1] = __builtin_nontemporal_load(xr + 128 * j + 1); } } else {
#pragma unroll
            for (int j = 0; j < 4; ++j) v[q][j] = (f32x4){0.f, 0.f, 0.f, 0.f}; } }
#pragma unroll
        for (int q = 0; q < 4; ++q) { const int mm = m + q * NGW; if (mm < M) rms_row_to_bf16(F, v[q], F.XN + (size_t)mm * D, F.xinv + mm); }
    }
    }
}

template <int HW> struct PoolItem {
    v4u w[8 + 2 * HW]; int S, t0, seq0, cc;
    __device__ __forceinline__ void load(Frame& F, int g, int rg, int lane) {
        const int row0 = rg * 32 + (lane >> 4) * 8; cc = g * 16 + (lane & 15);
        if (row0 < ROWS_P) { S = 4096; t0 = row0 & 4095; } else { S = 8192; t0 = (row0 - ROWS_P) & 8191; }
        seq0 = row0 - t0;
        const GAS v4u* ub = (const GAS v4u*)(F.U + (size_t)seq0 * 512 + cc * 8);
#pragma unroll
        for (int k = 0; k < 8 + 2 * HW; ++k) { const int j = t0 - HW + k; w[k] = (j >= 0 && j < S) ? __builtin_nontemporal_load(ub + (size_t)j * 64) : (v4u){0u, 0u, 0u, 0u}; }
    }
    __device__ __forceinline__ void finish(Frame& F) {
        float s0 = 0.f, s1 = 0.f, s2 = 0.f, s3 = 0.f, s4 = 0.f, s5 = 0.f, s6 = 0.f, s7 = 0.f;
#pragma unroll
        for (int k = 0; k < 2 * HW; ++k) { s0 += bflo(w[k].x); s1 += bfhi(w[k].x); s2 += bflo(w[k].y); s3 += bfhi(w[k].y); s4 += bflo(w[k].z); s5 += bfhi(w[k].z); s6 += bflo(w[k].w); s7 += bfhi(w[k].w); }
#pragma unroll
        for (int r = 0; r < 8; ++r) {
            const int t = t0 + r, lo = t - HW < 0 ? 0 : t - HW, hi = t + HW > S ? S : t + HW; const float inv = __builtin_amdgcn_rcpf((float)(hi - lo));
            const v4u c = w[r + HW];
            v4u o; o.x = pk2(s0 * inv - bflo(c.x), s1 * inv - bfhi(c.x)); o.y = pk2(s2 * inv - bflo(c.y), s3 * inv - bfhi(c.y)); o.z = pk2(s4 * inv - bflo(c.z), s5 * inv - bfhi(c.z)); o.w = pk2(s6 * inv - bflo(c.w), s7 * inv - bfhi(c.w));
            *(GAS v4u*)(F.MIX + (size_t)(seq0 + t) * 1024 + 512 + cc * 8) = o;
            if (r < 7) { const v4u a = w[r + 2 * HW], b = w[r];
                s0 += bflo(a.x) - bflo(b.x); s1 += bfhi(a.x) - bfhi(b.x); s2 += bflo(a.y) - bflo(b.y); s3 += bfhi(a.y) - bfhi(b.y); s4 += bflo(a.z) - bflo(b.z); s5 += bfhi(a.z) - bfhi(b.z); s6 += bflo(a.w) - bflo(b.w); s7 += bfhi(a.w) - bfhi(b.w); }
        }
    }
};
template <int HW> __device__ __forceinline__ void pool_wave(Frame& F, int g, int first, int stride) {
    constexpr int NRG = M / 32;
    if (HW <= 4 && first + 2 * stride < NRG && first + 3 * stride >= NRG) {
        PoolItem<HW> a, b; a.load(F, g, first, F.lane); b.load(F, g, first + stride, F.lane);
        a.finish(F); a.load(F, g, first + 2 * stride, F.lane); b.finish(F); a.finish(F);
    } else {
        for (int rg = first; rg < NRG; rg += stride) { PoolItem<HW> a; a.load(F, g, rg, F.lane); a.finish(F); }
    }
}
__device__ __forceinline__ void pool_role_big(Frame& F, int idx) { constexpr int NRG = M / 32;
    { PoolItem<8> a; a.load(F, 3, idx, F.lane); a.finish(F); }
    { PoolItem<8> b; b.load(F, 3, idx + NRG / 2, F.lane); b.finish(F); } }
__device__ __forceinline__ void pool_role_mid(Frame& F, int idx) { constexpr int NRG = M / 32;
    PoolItem<4> a, b, c; a.load(F, 2, idx, F.lane); b.load(F, 2, idx + NRG / 3, F.lane); a.finish(F); c.load(F, 2, idx + 2 * (NRG / 3), F.lane); b.finish(F); c.finish(F); }
__device__ __forceinline__ void pool_role_small(Frame& F, int idx) { constexpr int NRG = M / 32;
    PoolItem<2> a1, b1; PoolItem<1> a0, b0;
    a1.load(F, 1, idx, F.lane); b1.load(F, 1, idx + NRG / 2, F.lane); a1.finish(F); a0.load(F, 0, idx, F.lane); b1.finish(F); b0.load(F, 0, idx + NRG / 2, F.lane); a0.finish(F); b0.finish(F); }
__device__ __forceinline__ void pool_pass(Frame& F) {
    if (F.G == 256) {
        const int w = F.wave;
        if (w < 3) pool_role_big(F, F.vcu * 3 + w); else if (w < 5) pool_role_mid(F, F.vcu * 2 + (w - 3)); else pool_role_small(F, F.vcu * 3 + (w - 5));
        return;
    }
    const int gw = F.vcu * NWAVES + F.wave, NGW = F.G * NWAVES;
    const int g = gw & 3, first = gw >> 2, stride = NGW >> 2;
    if (g == 0) pool_wave<1>(F, 0, first, stride); else if (g == 1) pool_wave<2>(F, 1, first, stride); else if (g == 2) pool_wave<4>(F, 2, first, stride); else pool_wave<8>(F, 3, first, stride);
}

__device__ __forceinline__ void attn_decode(int L, long& rowbase, int& NT, int& h, int& qb, int& kvh) {
    const int i = L >> 8, v = L & 255, xcd = v >> 5, l = v & 31;
    if (i < 4) { const int combo = xcd * 2 + (i >> 1), b = combo >> 1; kvh = combo & 1; const int idx = (i & 1) * 32 + l; h = kvh * 4 + (idx >> 4); qb = idx & 15; rowbase = (long)b * 4096; NT = 64; }
    else { const int combo = xcd >> 1, b = combo >> 1; kvh = combo & 1; const int idx = (xcd & 1) * 64 + (i - 4) * 32 + l; h = kvh * 4 + (idx >> 5); qb = idx & 31; rowbase = (long)ROWS_P + (long)b * 8192; NT = 128; }
}
template <bool NOMAX> __device__ __forceinline__ void attn_all_t(Frame& F, char* lds, bf16* Obuf) {
    attn_body::bf16x8 qr[4] = {};
    bool first = true;
    for (int L = F.vcu; L < 1536; L += F.G) {
        long rowbase, n_rowbase; int NT, h, qb, kvh, n_NT, n_h, n_qb, n_kvh;
        attn_decode(L, rowbase, NT, h, qb, kvh);
        const bool has_next = L + F.G < 1536;
        attn_decode(has_next ? L + F.G : L, n_rowbase, n_NT, n_h, n_qb, n_kvh);
        const attn_body::bf16* Kh = (const attn_body::bf16*)F.KV + rowbase * 256 + kvh * 64;
        const attn_body::bf16* n_Kh = (const attn_body::bf16*)F.KV + n_rowbase * 256 + n_kvh * 64;
        attn_body::attn_unit<8, NOMAX>(rowbase, NT, h, qb, (const attn_body::bf16*)F.MIX, Kh, Kh + 128, (attn_body::bf16*)Obuf, lds, first, has_next, n_rowbase, n_h, n_qb, n_Kh, qr);
        first = false;
    }
}
__device__ __forceinline__ void attn_all(Frame& F, char* lds, bf16* Obuf) {
    float mq = 0.f, mk = 0.f;
    for (int i = 0; i < 64; ++i) { mq = fmaxf(mq, fabsf(F.qg[i])); mk = fmaxf(mk, fabsf(F.kg[i])); }
    const bool fast = 2.0f * (8.0f * 1.4426950408889634f) * mq * mk < 64.0f;
    if (fast) attn_all_t<true>(F, lds, Obuf); else attn_all_t<false>(F, lds, Obuf);
}

struct Args { const float* in[12]; float* out; unsigned char* ws; int ph_lo, ph_hi; };
__global__ void __launch_bounds__(NWAVES * 64, 2) mega_fwd(Args args) {
    extern __shared__ __attribute__((aligned(16))) unsigned char lds[];
    Frame F;
    F.lds = (LAS unsigned char*)lds;
    F.tid = threadIdx.x; F.lane = F.tid & 63; F.wave = __builtin_amdgcn_readfirstlane(F.tid >> 6);
    F.G = gridDim.x; { const int bx = blockIdx.x; F.vcu = (F.G % 8 == 0) ? (bx % 8) * (F.G / 8) + bx / 8 : bx; }
    unsigned char* ws = args.ws;
    F.xp = args.in[0]; F.xs = args.in[1]; F.g1 = args.in[2]; F.win = args.in[3]; F.qg = args.in[4]; F.kg = args.in[5]; F.wpool = args.in[6]; F.pscale = args.in[7];
    F.wout = args.in[8]; F.g2 = args.in[9]; F.wup = args.in[10]; F.wdn = args.in[11]; F.out = args.out;
    F.Win_t = (bf16*)(ws + WS_WIN); F.Wo_t = (bf16*)(ws + WS_WO); F.Wup_t = (bf16*)(ws + WS_WUP); F.Wdn_t = (bf16*)(ws + WS_WDN);
    F.XN = (bf16*)(ws + WS_XN); F.MIX = (bf16*)(ws + WS_MIX); F.KV = (bf16*)(ws + WS_KV); F.U = (bf16*)(ws + WS_U); F.H = (bf16*)(ws + WS_H);
    F.cosT = (float*)(ws + WS_ROPE); F.sinT = F.cosT + 2048; F.stats = (float*)(ws + WS_STATS); F.xinv = (float*)(ws + WS_XINV);
#if MK_N_LAUNCHES == 1
    cg::grid_group grid = cg::this_grid();
    for (int u = F.tid; u < (LDS_BYTES - LDSCTL_OFF) / 4; u += NWAVES * 64) ((LAS unsigned*)(F.lds + LDSCTL_OFF))[u] = 0u;
    __syncthreads();
    XcdBarrier bar = xcd_barrier_post((unsigned*)(ws + WS_CTL), (volatile LAS unsigned*)(F.lds + MISC_OFF) + 8);
#define GRID_BAR() do { if (args.ph_hi < 0) { asm volatile("s_waitcnt vmcnt(0)" ::: "memory"); grid.sync(); } else xcd_barrier(bar); } while (0)
#define GRID_BAR0() GRID_BAR()
#else
#define GRID_BAR0() do {} while (0)
#define GRID_BAR() do {} while (0)
#endif
    const int lo = args.ph_lo, hi = args.ph_hi < 0 ? -args.ph_hi : args.ph_hi;
#define IN(k) (lo <= (k) && (k) < hi)
#define BOTH(k) (IN(k) && IN((k) + 1))
    if (IN(0)) { p0_prologue(F);
#if PROBE_PH == 0
        p0_prologue(F);
#endif
        if (BOTH(0)) GRID_BAR0(); }
    if (IN(1)) {
        pg8::Gemm g{F.XN, F.Win_t, M, NIN, D}; pg8::StaticOrder S; S.init(M, NIN, F.G, (int)blockIdx.x);
        pg8::EpiInProj E{F.MIX, F.KV, F.U, F.qg, F.kg, F.cosT, F.sinT};
        pg8::gemm_phase<pg8::EpiInProj, pg8::StaticOrder, PG8_ALIGN, PG8_SP2>(F.lds + RING_OFF, g, S, E);
#if PROBE_PH == 1
        pg8::gemm_phase<pg8::EpiInProj, pg8::StaticOrder, PG8_ALIGN, PG8_SP2>(F.lds + RING_OFF, g, S, E);
#endif
        if (BOTH(1)) GRID_BAR();
    }
    if (IN(2)) {
        static_assert(attn_body::ATTN_LDS_BYTES <= RING_BYTES, "attention LDS");
        pool_pass(F);
#if PROBE_PH == 2
        attn_all(F, (char*)lds + RING_OFF, F.XN);
#endif
#if PROBE_PH == 7
        pool_pass(F);
#endif
        attn_all(F, (char*)lds + RING_OFF, F.MIX);
        if (BOTH(2)) GRID_BAR();
    }
    if (IN(3)) {
        pg8::Gemm g{F.MIX, F.Wo_t, M, D, D}; pg8::StaticOrder S; S.init(M, D, F.G, (int)blockIdx.x);
        const int g_ok = __syncthreads_and((fabsf(F.g1[F.tid]) >= 1e-3f && fabsf(F.g1[F.tid + 512]) >= 1e-3f) ? 1 : 0);
        if (g_ok) { pg8::EpiResStats<true> E{F.xp, F.xs, F.XN, F.stats, F.xinv, F.g1};
            pg8::gemm_phase<pg8::EpiResStats<true>, pg8::StaticOrder, PG8_ALIGN, PG8_SP2>(F.lds + RING_OFF, g, S, E); }
        else { pg8::EpiResStats<false> E{F.xp, F.xs, F.XN, F.stats, F.xinv, F.g1};
            pg8::gemm_phase<pg8::EpiResStats<false>, pg8::StaticOrder, PG8_ALIGN, PG8_SP2>(F.lds + RING_OFF, g, S, E); }
        if (BOTH(3)) GRID_BAR();
    }
    if (IN(4)) {
        pg8::Gemm g{F.XN, F.Wup_t, M, FF, D}; pg8::StaticOrder S; S.init(M, FF, F.G, (int)blockIdx.x);
        LAS float* tab = (LAS float*)(F.lds + UPTAB_OFF);
        { const int rowi = F.tid & 255;
          for (int i = F.tid >> 8; i < pg8::UP_TAB_ROUNDS; i += 2) { const int pm = S.pm_at(i); if (pm < 0) break;
              const f32x4* p = (const f32x4*)(F.stats + (size_t)(pm * 256 + rowi) * 16); const f32x4 a = p[0], b = p[1], c = p[2], d = p[3];
              const float ssum = ((a[0] + a[1]) + (a[2] + a[3])) + ((b[0] + b[1]) + (b[2] + b[3])) + ((c[0] + c[1]) + (c[2] + c[3])) + ((d[0] + d[1]) + (d[2] + d[3]));
              tab[i * 256 + rowi] = __builtin_amdgcn_rsqf(ssum * (1.0f / 1024.0f) + EPS); }
          __syncthreads(); }
        pg8::EpiUp E{F.H, F.stats, tab};
        pg8::gemm_phase<pg8::EpiUp, pg8::StaticOrder, PG8_ALIGN, PG8_SP2>(F.lds + RING_OFF, g, S, E);
#if PROBE_PH == 4
        pg8::gemm_phase<pg8::EpiUp, pg8::StaticOrder, PG8_ALIGN, PG8_SP2>(F.lds + RING_OFF, g, S, E);
#endif
        if (BOTH(4)) GRID_BAR();
    }
    if (IN(5)) {
        pg8::Gemm g{F.H, F.Wdn_t, M, D, FF}; pg8::StaticOrder S; S.init(M, D, F.G, (int)blockIdx.x, 1);
        pg8::EpiDown E{F.out, F.XN};
        pg8::gemm_phase<pg8::EpiDown, pg8::StaticOrder, PG8_ALIGN, PG8_SP2>(F.lds + RING_OFF, g, S, E);
#if PROBE_PH == 5
        pg8::gemm_phase<pg8::EpiDown, pg8::StaticOrder, PG8_ALIGN, PG8_SP2>(F.lds + RING_OFF, g, S, E);
#endif
    }
#undef IN
#undef BOTH
}

extern "C" void kernel_launch(void* const* d_in, const int* in_sizes, int n_in, void* d_out, int out_size, void* d_ws, size_t ws_size, hipStream_t stream) {
    static int grid = 0;
    if (grid == 0) {
        if (n_in != 12 || in_sizes[0] != ROWS_P * D || in_sizes[1] != (M - ROWS_P) * D || out_size != M * D || ws_size < WS_END) {
            fprintf(stderr, "kernel_launch: shape / workspace mismatch (n_in %d, out %d, ws %zu < %zu); nothing launched\n", n_in, out_size, ws_size, (size_t)WS_END); grid = -1; return; }
        int dev = 0, cus = 0, per_cu = 0;
        if (hipGetDevice(&dev) != hipSuccess || hipDeviceGetAttribute(&cus, hipDeviceAttributeMultiprocessorCount, dev) != hipSuccess) { grid = -1; return; }
        if (hipFuncSetAttribute((const void*)mega_fwd, hipFuncAttributeMaxDynamicSharedMemorySize, LDS_BYTES) != hipSuccess) { fprintf(stderr, "kernel_launch: hipFuncSetAttribute failed\n"); grid = -1; return; }
        if (hipOccupancyMaxActiveBlocksPerMultiprocessor(&per_cu, (const void*)mega_fwd, NWAVES * 64, LDS_BYTES) != hipSuccess || per_cu < 1) { fprintf(stderr, "kernel_launch: occupancy query says %d\n", per_cu); per_cu = 1; }
        (void)hipGetLastError();
        grid = cus * per_cu;
    }
    if (grid < 0) return;
    Args a{};
    for (int i = 0; i < 12; ++i) a.in[i] = (const float*)d_in[i];
    a.out = (float*)d_out; a.ws = (unsigned char*)d_ws;
#if MK_N_LAUNCHES == 1
    a.ph_lo = 0; a.ph_hi = PER_PHASE;
    if (hipMemsetAsync((char*)d_ws + WS_CTL, 0, CTL_ZERO_BYTES, stream) != hipSuccess) { fprintf(stderr, "kernel_launch: memset of the barrier words failed\n"); return; }
    void* kargs[] = {&a};
    hipError_t e = hipLaunchCooperativeKernel((const void*)mega_fwd, dim3(grid), dim3(NWAVES * 64), kargs, LDS_BYTES, stream);
    if (e != hipSuccess) fprintf(stderr, "kernel_launch: cooperative launch failed: %s (grid %d)\n", hipGetErrorString(e), grid);
#else
    for (int li = 0; li < PER_PHASE; ++li) { a.ph_lo = li; a.ph_hi = li + 1; hipLaunchKernelGGL(mega_fwd, dim3(grid), dim3(NWAVES * 64), LDS_BYTES, stream, a); }
#endif
}
```
